# Optimizing an MI355X kernel written in HIP

```python
import jax
import jax.numpy as jnp
from jax import lax
import numpy as np

D_MODEL = 1024
BATCH = 32
SEQ = 2048
DEPTH = 1
DEC_BATCH = 1
DEC_SEQ = 16384
PAST_LEN = 128

N_META = 16
H_A = 8
Q_LORA = 256
KV_LORA = 128
NOPE = 64
ROPE = 32
QK_DIM = NOPE + ROPE
V_DIM = 64
ROPE_THETA = 10000.0
Q_BLOCK = 128
H_B = 4
DH_B = 128
CHUNK = 64
NEG = -1e30
D_FF = 2816
CONV_W = 3
EPS = 1e-6
IN_SIZES = (Q_LORA, KV_LORA, ROPE, H_B * DH_B, H_B * DH_B, H_B * DH_B, H_B * DH_B, 2 * H_B, 2 * H_B, D_MODEL, D_MODEL)
IN_COLS = sum(IN_SIZES)

kernel_name = "hybrid_mla_mlstm_encoder"


def _rmsnorm(x, g):
    xf = x.astype(jnp.float32)
    y = xf * lax.rsqrt(jnp.mean(xf * xf, axis=-1, keepdims=True) + EPS)
    return (y * g.astype(jnp.float32)).astype(x.dtype)


def _rope_tables(L):
    inv = ROPE_THETA ** (-jnp.arange(0, ROPE, 2, dtype=jnp.float32) / ROPE)
    ang = jnp.arange(L, dtype=jnp.float32)[:, None] * inv[None, :]
    return jnp.cos(ang), jnp.sin(ang)


def _rope(x, cos, sin):
    x1, x2 = jnp.split(x.astype(jnp.float32), 2, axis=-1)
    c = cos[:, None, :]
    s = sin[:, None, :]
    return jnp.concatenate([x1 * c - x2 * s, x1 * s + x2 * c], axis=-1).astype(x.dtype)


def _block_attention(q, k, v):
    B, H, L, dq = q.shape
    nb = -(-L // Q_BLOCK)
    Lq = nb * Q_BLOCK
    qp = jnp.pad(q, ((0, 0), (0, 0), (0, Lq - L), (0, 0)))
    qb = jnp.moveaxis(qp.reshape(B, H, nb, Q_BLOCK, dq), 2, 0)
    scale = QK_DIM ** -0.5

    def block(qi):
        s = jnp.einsum('bhqd,bhkd->bhqk', qi, k).astype(jnp.float32) * scale
        p = jax.nn.softmax(s, axis=-1)
        return jnp.einsum('bhqk,bhkd->bhqd', p.astype(v.dtype), v)

    o = lax.map(block, qb)
    return jnp.moveaxis(o, 0, 2).reshape(B, H, Lq, v.shape[-1])[:, :, :L]


def _mlstm_dir(q, k, v, i_pre, log_f):
    B, H, T, dk = q.shape
    dv = v.shape[-1]
    N = T // CHUNK
    f32 = jnp.float32
    qc = q.reshape(B, H, N, CHUNK, dk).astype(f32)
    kc = k.reshape(B, H, N, CHUNK, dk).astype(f32) * (dk ** -0.5)
    vc = v.reshape(B, H, N, CHUNK, dv).astype(f32)
    ic = i_pre.reshape(B, H, N, CHUNK)
    bc = jnp.cumsum(log_f.reshape(B, H, N, CHUNK), axis=-1)
    gc = bc[..., -1]
    a = gc[..., None] - bc + ic
    m_loc = jnp.max(a, axis=-1)
    w = jnp.exp(a - m_loc[..., None])
    dC = jnp.einsum('bhncd,bhnce->bhnde', kc * w[..., None], vc)
    dn = jnp.einsum('bhncd,bhnc->bhnd', kc, w)

    def step(carry, xs):
        C, n, m = carry
        dC_, dn_, g_, ml_ = xs
        m_new = jnp.maximum(g_ + m, ml_)
        sp = jnp.exp(g_ + m - m_new)
        sl = jnp.exp(ml_ - m_new)
        C_new = sp[..., None, None] * C + sl[..., None, None] * dC_
        n_new = sp[..., None] * n + sl[..., None] * dn_
        return (C_new, n_new, m_new), (C, n, m)

    init = (jnp.zeros((B, H, dk, dv), f32), jnp.zeros((B, H, dk), f32), jnp.full((B, H), NEG, f32))
    xs = (jnp.moveaxis(dC, 2, 0), jnp.moveaxis(dn, 2, 0), jnp.moveaxis(gc, 2, 0), jnp.moveaxis(m_loc, 2, 0))
    _, (Cs, ns, ms) = lax.scan(step, init, xs)
    Cs = jnp.moveaxis(Cs, 0, 2)
    ns = jnp.moveaxis(ns, 0, 2)
    ms = jnp.moveaxis(ms, 0, 2)

    D = bc[..., :, None] - bc[..., None, :] + ic[..., None, :]
    tril = jnp.tril(jnp.ones((CHUNK, CHUNK), dtype=bool))
    D = jnp.where(tril, D, -jnp.inf)
    inter = bc + ms[..., None]
    m_t = jnp.maximum(jnp.max(D, axis=-1), inter)
    P = jnp.exp(D - m_t[..., None])
    s = jnp.einsum('bhntd,bhnsd->bhnts', qc, kc) * P
    e_in = jnp.exp(inter - m_t)
    num = jnp.einsum('bhnts,bhnse->bhnte', s, vc) + e_in[..., None] * jnp.einsum('bhntd,bhnde->bhnte', qc, Cs)
    den = jnp.sum(s, axis=-1) + e_in * jnp.einsum('bhntd,bhnd->bhnt', qc, ns)
    h = num / jnp.maximum(jnp.abs(den), jnp.exp(-m_t))[..., None]
    return h.reshape(B, H, T, dv)


def _mixer(u, cos, sin, valid, w_in, q_norm, w_uq, kv_norm, w_ukv, b_igate, b_fgate, mlstm_norm,
           w_o_attn, w_o_mlstm, w_out):
    B, L, _ = u.shape
    z = u @ w_in
    points = np.cumsum(IN_SIZES)[:-1].tolist()
    z_q, z_kv, z_kr, m_q, m_k, m_v, m_o, z_i, z_f, z_ga, z_gb = jnp.split(z, points, axis=-1)

    q = (_rmsnorm(z_q, q_norm) @ w_uq).reshape(B, L, H_A, QK_DIM)
    q = jnp.concatenate([q[..., :NOPE], _rope(q[..., NOPE:], cos, sin)], axis=-1)
    kv = (_rmsnorm(z_kv, kv_norm) @ w_ukv).reshape(B, L, H_A, NOPE + V_DIM)
    k_r = _rope(z_kr[:, :, None, :], cos, sin)
    k = jnp.concatenate([kv[..., :NOPE], jnp.broadcast_to(k_r, (B, L, H_A, ROPE))], axis=-1)
    v = kv[..., NOPE:]
    attn = _block_attention(q.transpose(0, 2, 1, 3), k.transpose(0, 2, 1, 3), v.transpose(0, 2, 1, 3))
    attn = attn.transpose(0, 2, 1, 3).reshape(B, L, H_A * V_DIM)

    pad = CHUNK - N_META

    def heads(t):
        t = jnp.pad(t.reshape(B, L, H_B, DH_B), ((0, 0), (pad, 0), (0, 0), (0, 0)))
        return t.transpose(0, 2, 1, 3)

    mq, mk, mv = heads(m_q), heads(m_k), heads(m_v)
    gi = z_i.reshape(B, L, 2, H_B).astype(jnp.float32) + b_igate.astype(jnp.float32)
    gf = z_f.reshape(B, L, 2, H_B).astype(jnp.float32) + b_fgate.astype(jnp.float32)
    gi = jnp.pad(gi, ((0, 0), (pad, 0), (0, 0), (0, 0))).transpose(2, 0, 3, 1)
    gf = jnp.pad(gf, ((0, 0), (pad, 0), (0, 0), (0, 0))).transpose(2, 0, 3, 1)
    gi = jnp.where(valid, gi, NEG)
    log_f = jnp.where(valid, jax.nn.log_sigmoid(gf), 0.0)
    h_fwd = _mlstm_dir(mq, mk, mv, gi[0], log_f[0])
    h_bwd = jnp.flip(_mlstm_dir(jnp.flip(mq, 2), jnp.flip(mk, 2), jnp.flip(mv, 2),
                                jnp.flip(gi[1], -1), jnp.flip(log_f[1], -1)), 2)
    hm = (h_fwd + h_bwd)[:, :, pad:].transpose(0, 2, 1, 3).astype(u.dtype)
    hm = _rmsnorm(hm, mlstm_norm.reshape(H_B, DH_B)) * jax.nn.sigmoid(m_o).reshape(B, L, H_B, DH_B)
    hm = hm.reshape(B, L, H_B * DH_B)

    y = jax.nn.sigmoid(z_ga) * (attn @ w_o_attn) + jax.nn.sigmoid(z_gb) * (hm @ w_o_mlstm)
    return y @ w_out


def _conv_ffn(u, w_up, w_gate, conv_w, conv_b, w_down):
    L = u.shape[1]
    a = u @ w_up
    half = CONV_W // 2
    ap = jnp.pad(a, ((0, 0), (half, half), (0, 0)))
    a = sum(ap[:, j:j + L] * conv_w[j] for j in range(CONV_W)) + conv_b
    return (jax.nn.gelu(a, approximate=True) * (u @ w_gate)) @ w_down


def _encode(x, meta_tokens, norm_mix, w_in, q_norm, w_uq, kv_norm, w_ukv, b_igate, b_fgate, mlstm_norm,
            w_o_attn, w_o_mlstm, w_out, norm_ffn, w_up, w_gate, conv_w, conv_b, w_down, norm_final):
    B, S, _ = x.shape
    meta = jnp.broadcast_to(meta_tokens.astype(x.dtype)[None], (B, N_META, D_MODEL))
    h = jnp.concatenate([meta, x], axis=1)
    L = N_META + S
    cos, sin = _rope_tables(L)
    valid = jnp.arange(CHUNK + S) >= (CHUNK - N_META)
    for l in range(DEPTH):
        h = h + _mixer(_rmsnorm(h, norm_mix[l]), cos, sin, valid, w_in[l], q_norm[l], w_uq[l], kv_norm[l],
                       w_ukv[l], b_igate[l], b_fgate[l], mlstm_norm[l], w_o_attn[l], w_o_mlstm[l], w_out[l])
        h = h + _conv_ffn(_rmsnorm(h, norm_ffn[l]), w_up[l], w_gate[l], conv_w[l], conv_b[l], w_down[l])
    return _rmsnorm(h, norm_final)[:, N_META:]


def setup_inputs(seed: int = 0) -> dict:
    key = jax.random.key(seed)
    ks = jax.random.split(key, 24)
    f32 = jnp.float32

    def nrm(k, shape, fan):
        return jax.random.normal(k, shape, f32) * (fan ** -0.5)

    def gain(k, shape):
        return 1.0 + 0.01 * jax.random.normal(k, shape, f32)

    Ld = DEPTH
    return {
        "x_prompt": jax.random.normal(ks[0], (BATCH, SEQ, D_MODEL), f32),
        "x_sample": jax.random.normal(ks[1], (DEC_BATCH, DEC_SEQ, D_MODEL), f32),
        "meta_tokens": jax.random.normal(ks[2], (N_META, D_MODEL), f32),
        "norm_mix": gain(ks[3], (Ld, D_MODEL)),
        "w_in": nrm(ks[4], (Ld, D_MODEL, IN_COLS), D_MODEL),
        "q_norm": gain(ks[5], (Ld, Q_LORA)),
        "w_uq": nrm(ks[6], (Ld, Q_LORA, H_A * QK_DIM), Q_LORA),
        "kv_norm": gain(ks[7], (Ld, KV_LORA)),
        "w_ukv": nrm(ks[8], (Ld, KV_LORA, H_A * (NOPE + V_DIM)), KV_LORA),
        "b_igate": 0.1 * jax.random.normal(ks[9], (Ld, 2, H_B), f32),
        "b_fgate": jnp.linspace(3.0, 6.0, H_B, dtype=f32) + 0.1 * jax.random.normal(ks[10], (Ld, 2, H_B), f32),
        "mlstm_norm": gain(ks[11], (Ld, H_B * DH_B)),
        "w_o_attn": nrm(ks[12], (Ld, H_A * V_DIM, D_MODEL), H_A * V_DIM),
        "w_o_mlstm": nrm(ks[13], (Ld, H_B * DH_B, D_MODEL), H_B * DH_B),
        "w_out": nrm(ks[14], (Ld, D_MODEL, D_MODEL), D_MODEL),
        "norm_ffn": gain(ks[15], (Ld, D_MODEL)),
        "w_up": nrm(ks[16], (Ld, D_MODEL, D_FF), D_MODEL),
        "w_gate": nrm(ks[17], (Ld, D_MODEL, D_FF), D_MODEL),
        "conv_w": nrm(ks[18], (Ld, CONV_W, D_FF), CONV_W),
        "conv_b": 0.01 * jax.random.normal(ks[19], (Ld, D_FF), f32),
        "w_down": nrm(ks[20], (Ld, D_FF, D_MODEL), D_FF),
        "norm_final": gain(ks[21], (D_MODEL,)),
    }


def reference(x_prompt, x_sample, meta_tokens, norm_mix, w_in, q_norm, w_uq, kv_norm, w_ukv, b_igate, b_fgate,
              mlstm_norm, w_o_attn, w_o_mlstm, w_out, norm_ffn, w_up, w_gate, conv_w, conv_b, w_down, norm_final):
    y_prompt = _encode(x_prompt, meta_tokens, norm_mix, w_in, q_norm, w_uq, kv_norm, w_ukv, b_igate, b_fgate,
                       mlstm_norm, w_o_attn, w_o_mlstm, w_out, norm_ffn, w_up, w_gate, conv_w, conv_b, w_down,
                       norm_final)
    y_sample = _encode(x_sample, meta_tokens, norm_mix, w_in, q_norm, w_uq, kv_norm, w_ukv, b_igate, b_fgate,
                       mlstm_norm, w_o_attn, w_o_mlstm, w_out, norm_ffn, w_up, w_gate, conv_w, conv_b, w_down,
                       norm_final)
    return (y_prompt, y_sample)
```

```cpp
#include <hip/hip_runtime.h>
#include <hip/hip_cooperative_groups.h>
#include <cstdio>
#include <cstdint>
#include <cmath>
namespace cg = cooperative_groups;

#ifndef MK_MULTI_LAUNCH
#define MK_MULTI_LAUNCH 0
#endif

constexpr int DM = 1024, NB_P = 32, S_P = 2048, L_P = 2064, L_S = 16400, NMETA = 16;
constexpr int M_P = NB_P * L_P;
constexpr int M_TOK = M_P + L_S;
constexpr int MP = 82688;
constexpr int NSEQ = 33;
constexpr int ZW = 2560;
constexpr int DFF = 2816;
constexpr float EPS = 1e-6f;
constexpr float QSCALE = 0.10206207261596577f * 1.4426950408889634f;

namespace pg8 {
#define PG8_LAS __attribute__((address_space(3)))
typedef unsigned short bf16_t;
typedef short bf16x8 __attribute__((ext_vector_type(8)));
typedef float f32x4 __attribute__((ext_vector_type(4)));
typedef unsigned u32x4 __attribute__((ext_vector_type(4)));
constexpr int BM = 256, BK = 64, HALF = 128, HTB = HALF * BK * 2  , STAGE_BYTES = 8 * HTB, NXCD = 8, WGM = 8;

__host__ __device__ __forceinline__ int lds_byte(int r, int c) { const int st = (r >> 4) * 2 + (c >> 5), rr = r & 15, cc = c & 31, ob = rr * 64 + cc * 2; return st * 1024 + (ob ^ (((ob >> 9) & 1) << 5)); }
__host__ __device__ __forceinline__ void stage_rc(int b, int& R, int& C) { const int st = b / 1024, sb = b % 1024, swz = sb ^ (((sb >> 9) & 1) << 5); R = (st >> 1) * 16 + swz / 64; C = (st & 1) * 32 + (swz % 64) / 2; }
__host__ __device__ __forceinline__ int perm32(int rho) { const int n = rho >> 4, i = rho & 15; return 8 * (i >> 2) + 4 * n + (i & 3); }

struct Unit { int pm, pn; };
struct Gemm { const bf16_t* A; const bf16_t* Bt; int M, N, K, lda, ovl; };

struct StaticOrder {
    int nM, nN, nwg, G, c;
    __host__ __device__ void init(int M, int N, int G_, int c_) { nM = M / BM; nN = N / BM; nwg = nM * nN; G = G_; c = c_; }
    __host__ __device__ bool next(int i, Unit& u) const {
        const long L = (long)i * G + c; if (L >= nwg) return false;
        int wgid = (int)L; { const int q = nwg / NXCD, r = nwg % NXCD, xcd = wgid % NXCD, off = wgid / NXCD; wgid = (xcd < r ? xcd * (q + 1) : r * (q + 1) + (xcd - r) * q) + off; }
        const int nig = WGM * nN, gid = wgid / nig, fm = gid * WGM, gsz = (nM - fm) < WGM ? (nM - fm) : WGM;
        u.pm = fm + ((wgid % nig) % gsz); u.pn = (wgid % nig) / gsz; return true;
    }
    __device__ __forceinline__ void a_ready(const Unit&) const {}
    __device__ __forceinline__ void done(const Unit&) const {}
};

__device__ __forceinline__ unsigned cvt_pk_bf16(float lo, float hi) { unsigned r; asm volatile("v_cvt_pk_bf16_f32 %0, %1, %2" : "=v"(r) : "v"(lo), "v"(hi)); return r; }
template <class Epi, class Sched, bool ALIGN_EPI = false, bool SP2 = false>
__device__ __forceinline__ void gemm_phase(PG8_LAS unsigned char* lds, const Gemm g, const Sched& S, const Epi& E) {
    int tid_ = threadIdx.x; asm volatile("" : "+v"(tid_));
    const int tid = tid_, wid = __builtin_amdgcn_readfirstlane(tid >> 6), lane = tid & 63, wr = wid >> 2, wc = wid & 3, fr = lane & 15, fq = lane >> 4;
    const int K = g.K, nt = K / BK;
    unsigned voffA[2], voffB[2];
#pragma unroll
    for (int i = 0; i < 2; ++i) { int R, C; stage_rc(tid * 16 + i * 8192, R, C); const int Rb = Epi::PERM ? ((R & ~31) + perm32(R & 31)) : R;
        const int Ra = g.ovl ? (R - 2 * (R >> 6)) : R; voffA[i] = (unsigned)(Ra * g.lda + C) * 2u; voffB[i] = (unsigned)(Rb * K + C) * 2u; }
    const size_t kstep = (size_t)(BK * 2);
    const size_t hstepB = (size_t)HALF * K * 2, hstepA = (size_t)(g.ovl ? 124 : 128) * g.lda * 2;
    const size_t tstepB = 2 * hstepB, tstepA = 2 * hstepA;
    const unsigned ldsw = (unsigned)wid * 1024u;
    const int aoff = lds_byte(wr * 64 + fr, fq * 8), boff = lds_byte(wc * 32 + fr, fq * 8);
#define PG8_SA(b, h) (((b) * 2 + (h)) * HTB)
#define PG8_SB(b, h) ((4 + (b) * 2 + (h)) * HTB)
#define PG8_STAGE(bufoff, gbase, voff) do { _Pragma("unroll") for (int _i = 0; _i < 2; ++_i) \
        __builtin_amdgcn_global_load_lds((const unsigned*)((const char*)(gbase) + (voff)[_i]), (PG8_LAS unsigned*)(lds + (bufoff) + ldsw + _i * 8192), 16, 0, 0); } while (0)
#define PG8_LDA(dst, b, h) do { _Pragma("unroll") for (int m = 0; m < 4; ++m) _Pragma("unroll") for (int k = 0; k < 2; ++k) dst[m][k] = *(const PG8_LAS bf16x8*)(lds + PG8_SA(b, h) + aoff + m * 2048 + k * 1024); } while (0)
#define PG8_LDB(dst, b, h) do { _Pragma("unroll") for (int n = 0; n < 2; ++n) _Pragma("unroll") for (int k = 0; k < 2; ++k) dst[n][k] = *(const PG8_LAS bf16x8*)(lds + PG8_SB(b, h) + boff + n * 2048 + k * 1024); } while (0)
#define PG8_MMA(ai, bj, At, Bt) do { __builtin_amdgcn_s_setprio(1); _Pragma("unroll") for (int m = 0; m < 4; ++m) _Pragma("unroll") for (int n = 0; n < 2; ++n) _Pragma("unroll") for (int k = 0; k < 2; ++k) \
        acc[ai][bj][m][n] = __builtin_amdgcn_mfma_f32_16x16x32_bf16(Bt[n][k], At[m][k], acc[ai][bj][m][n], 0, 0, 0); __builtin_amdgcn_s_setprio(0); } while (0)
#define PG8_WAIT_V(n) asm volatile("s_waitcnt vmcnt(" #n ")" ::: "memory")
#define PG8_WAIT_L(n) asm volatile("s_waitcnt lgkmcnt(" #n ")" ::: "memory")
#define PG8_BAR __builtin_amdgcn_s_barrier()
#define PG8_SCHED __builtin_amdgcn_sched_barrier(0)
    Unit cur, nxt; int ui = 0;
    if (!S.next(0, cur)) return;
    f32x4 acc[2][2][4][2];
#pragma unroll
    for (int a = 0; a < 2; ++a)
#pragma unroll
        for (int b = 0; b < 2; ++b)
#pragma unroll
            for (int m = 0; m < 4; ++m)
#pragma unroll
                for (int n = 0; n < 2; ++n) acc[a][b][m][n] = (f32x4){0.f, 0.f, 0.f, 0.f};
    bf16x8 At[4][2], B0[2][2], B1[2][2];
    const char* cA = (const char*)g.A + (size_t)cur.pm * tstepA; const char* cB = (const char*)g.Bt + (size_t)cur.pn * tstepB;
    S.a_ready(cur);
    if constexpr (SP2) {
        PG8_STAGE(PG8_SB(0, 0), cB, voffB); PG8_STAGE(PG8_SB(0, 1), cB + hstepB, voffB); PG8_STAGE(PG8_SA(0, 0), cA, voffA); PG8_STAGE(PG8_SA(0, 1), cA + hstepA, voffA);
        if (wr == 1) PG8_BAR;
        PG8_WAIT_V(2); PG8_BAR;
        PG8_STAGE(PG8_SB(1, 0), cB + kstep, voffB); PG8_STAGE(PG8_SA(1, 0), cA + kstep, voffA); PG8_STAGE(PG8_SB(1, 1), cB + hstepB + kstep, voffB);
        PG8_WAIT_V(6); PG8_BAR;
    } else {
        PG8_STAGE(PG8_SB(0, 0), cB, voffB); PG8_STAGE(PG8_SA(0, 0), cA, voffA); PG8_STAGE(PG8_SB(0, 1), cB + hstepB, voffB); PG8_STAGE(PG8_SA(0, 1), cA + hstepA, voffA);
        if (wr == 1) PG8_BAR;
        PG8_WAIT_V(4); PG8_BAR;
        PG8_STAGE(PG8_SB(1, 0), cB + kstep, voffB); PG8_STAGE(PG8_SA(1, 0), cA + kstep, voffA); PG8_STAGE(PG8_SB(1, 1), cB + hstepB + kstep, voffB);
        PG8_WAIT_V(6); PG8_BAR;
    }
    for (;;) {
        const bool has_next = S.next(ui + 1, nxt);
        const char* nA = has_next ? (const char*)g.A + (size_t)nxt.pm * tstepA : cA; const char* nB = has_next ? (const char*)g.Bt + (size_t)nxt.pn * tstepB : cB;
        for (int t = 0; t < nt; t += 2) {
            const bool last = (t == nt - 2);
            const char* a1 = cA + (size_t)(t + 1) * kstep;
            const char* a2 = last ? nA : cA + (size_t)(t + 2) * kstep; const char* b2 = last ? nB : cB + (size_t)(t + 2) * kstep;
            const char* a3 = a2 + kstep; const char* b3 = b2 + kstep;
            if (last && has_next) S.a_ready(nxt);
            if constexpr (SP2) {
            PG8_LDB(B0, 0, 0); PG8_LDB(B1, 0, 1); PG8_SCHED; PG8_LDA(At, 0, 0); PG8_STAGE(PG8_SA(1, 1), a1 + hstepA, voffA);
            PG8_WAIT_V(8); PG8_WAIT_L(0); PG8_BAR; PG8_MMA(0, 0, At, B0); PG8_MMA(0, 1, At, B1); PG8_BAR; PG8_SCHED;
            PG8_LDA(At, 0, 1); PG8_STAGE(PG8_SB(0, 0), b2, voffB); PG8_STAGE(PG8_SB(0, 1), b2 + hstepB, voffB); PG8_STAGE(PG8_SA(0, 0), a2, voffA);
            PG8_WAIT_V(8); PG8_WAIT_L(0); PG8_BAR; PG8_MMA(1, 0, At, B0); PG8_MMA(1, 1, At, B1); PG8_BAR; PG8_SCHED;
            PG8_LDB(B0, 1, 0); PG8_LDB(B1, 1, 1); PG8_SCHED; PG8_LDA(At, 1, 0); PG8_STAGE(PG8_SA(0, 1), a2 + hstepA, voffA);
            PG8_WAIT_V(8); PG8_WAIT_L(0); PG8_BAR; PG8_MMA(0, 0, At, B0); PG8_MMA(0, 1, At, B1); PG8_BAR; PG8_SCHED;
            PG8_LDA(At, 1, 1); PG8_STAGE(PG8_SB(1, 0), b3, voffB); PG8_STAGE(PG8_SB(1, 1), b3 + hstepB, voffB); PG8_STAGE(PG8_SA(1, 0), a3, voffA);
            PG8_WAIT_V(8); PG8_WAIT_L(0); PG8_BAR; PG8_MMA(1, 0, At, B0); PG8_MMA(1, 1, At, B1); PG8_BAR; PG8_SCHED;
            } else {
            PG8_LDB(B0, 0, 0); PG8_SCHED; PG8_LDA(At, 0, 0); PG8_STAGE(PG8_SA(1, 1), a1 + hstepA, voffA);
            PG8_WAIT_L(8); PG8_BAR; PG8_WAIT_L(0); PG8_MMA(0, 0, At, B0); PG8_BAR; PG8_SCHED;
            PG8_LDB(B1, 0, 1); PG8_STAGE(PG8_SB(0, 0), b2, voffB);
            PG8_BAR; PG8_WAIT_L(0); PG8_MMA(0, 1, At, B1); PG8_BAR;
            PG8_LDA(At, 0, 1); PG8_STAGE(PG8_SA(0, 0), a2, voffA);
            PG8_BAR; PG8_WAIT_L(0); PG8_MMA(1, 0, At, B0); PG8_BAR; PG8_SCHED;
            PG8_STAGE(PG8_SB(0, 1), b2 + hstepB, voffB);
            PG8_WAIT_V(6); PG8_BAR; PG8_MMA(1, 1, At, B1); PG8_BAR;
            PG8_LDB(B0, 1, 0); PG8_SCHED; PG8_LDA(At, 1, 0); PG8_STAGE(PG8_SA(0, 1), a2 + hstepA, voffA);
            PG8_WAIT_L(8); PG8_BAR; PG8_WAIT_L(0); PG8_MMA(0, 0, At, B0); PG8_BAR; PG8_SCHED;
            PG8_LDB(B1, 1, 1); PG8_STAGE(PG8_SB(1, 0), b3, voffB);
            PG8_BAR; PG8_WAIT_L(0); PG8_MMA(0, 1, At, B1); PG8_BAR;
            PG8_LDA(At, 1, 1); PG8_STAGE(PG8_SA(1, 0), a3, voffA);
            PG8_BAR; PG8_WAIT_L(0); PG8_MMA(1, 0, At, B0); PG8_BAR; PG8_SCHED;
            PG8_STAGE(PG8_SB(1, 1), b3 + hstepB, voffB);
            PG8_WAIT_V(6); PG8_BAR; PG8_MMA(1, 1, At, B1); PG8_BAR;
            }
        }
        if constexpr (ALIGN_EPI) { if (wr == 0) PG8_BAR; }
        if constexpr (!Epi::AFTER_DRAIN) { E(acc, cur, wr, wc, fr, fq); S.done(cur); }
        if (!has_next) break;
#pragma unroll
        for (int a = 0; a < 2; ++a)
#pragma unroll
            for (int b = 0; b < 2; ++b)
#pragma unroll
                for (int m = 0; m < 4; ++m)
#pragma unroll
                    for (int n = 0; n < 2; ++n) acc[a][b][m][n] = (f32x4){0.f, 0.f, 0.f, 0.f};
        cur = nxt; cA = nA; cB = nB; ++ui;
        if constexpr (ALIGN_EPI) { if (wr == 1) PG8_BAR; }
    }
    PG8_WAIT_V(0);
    if constexpr (!ALIGN_EPI) { if (wr == 0) PG8_BAR; }
    PG8_BAR;
    if constexpr (Epi::AFTER_DRAIN) { E.fused(acc, cur, wr, wc, fr, fq, lds, wid, lane); S.done(cur); }
#undef PG8_SA
#undef PG8_SB
#undef PG8_STAGE
#undef PG8_LDA
#undef PG8_LDB
#undef PG8_MMA
#undef PG8_WAIT_V
#undef PG8_WAIT_L
#undef PG8_BAR
#undef PG8_SCHED
}
}

#define LAS __attribute__((address_space(3)))
typedef unsigned short bf16_t;
typedef short bf16x8 __attribute__((ext_vector_type(8)));
typedef short s16x4 __attribute__((ext_vector_type(4)));
typedef float f32x4 __attribute__((ext_vector_type(4)));
typedef unsigned u32x4 __attribute__((ext_vector_type(4)));
typedef unsigned u32x2 __attribute__((ext_vector_type(2)));
typedef float f32x2_t __attribute__((ext_vector_type(2))); typedef __bf16 bf16x2_t __attribute__((ext_vector_type(2)));
__device__ __forceinline__ unsigned cvt_pk_bf16(float lo, float hi) { f32x2_t v = {lo, hi}; bf16x2_t b = __builtin_convertvector(v, bf16x2_t); return __builtin_bit_cast(unsigned, b); }
#define MFMA16(a, b, c) __builtin_amdgcn_mfma_f32_16x16x32_bf16((a), (b), (c), 0, 0, 0)
__device__ __forceinline__ float bf_lo(unsigned w) { return __uint_as_float(w << 16); }
__device__ __forceinline__ float bf_hi(unsigned w) { return __uint_as_float(w & 0xffff0000u); }
__device__ __forceinline__ float bf2f(bf16_t h) { return __uint_as_float(((unsigned)h) << 16); }
__device__ __forceinline__ bf16_t f2bf(float f) { return (bf16_t)(cvt_pk_bf16(f, 0.f) & 0xffffu); }
__device__ __forceinline__ float sigmoidf_(float x) { return __builtin_amdgcn_rcpf(1.0f + __builtin_amdgcn_exp2f(-1.4426950408889634f * x)); }
__device__ __forceinline__ float rsqrt_(float x) { return __builtin_amdgcn_rsqf(x); }
__device__ __forceinline__ float xmax_16_32(float v) {
    auto r = __builtin_amdgcn_permlane16_swap(__float_as_uint(v), __float_as_uint(v), false, false);
    v = fmaxf(__uint_as_float(r[0]), __uint_as_float(r[1]));
    auto q = __builtin_amdgcn_permlane32_swap(__float_as_uint(v), __float_as_uint(v), false, false);
    return fmaxf(__uint_as_float(q[0]), __uint_as_float(q[1]));
}
__device__ __forceinline__ float xsum_16_32(float v) {
    auto r = __builtin_amdgcn_permlane16_swap(__float_as_uint(v), __float_as_uint(v), false, false);
    v = __uint_as_float(r[0]) + __uint_as_float(r[1]);
    auto q = __builtin_amdgcn_permlane32_swap(__float_as_uint(v), __float_as_uint(v), false, false);
    return __uint_as_float(q[0]) + __uint_as_float(q[1]);
}
__device__ __forceinline__ float row_prev(float v) { return __int_as_float(__builtin_amdgcn_mov_dpp(__float_as_int(v), 0x121, 0xf, 0xf, false)); }
__device__ __forceinline__ float row_next(float v) { return __int_as_float(__builtin_amdgcn_mov_dpp(__float_as_int(v), 0x12F, 0xf, 0xf, false)); }
__device__ __forceinline__ float wave_scan_sum(float v, int lane) {
    v += __int_as_float(__builtin_amdgcn_update_dpp(0, __float_as_int(v), 0x111, 0xf, 0xf, false));
    v += __int_as_float(__builtin_amdgcn_update_dpp(0, __float_as_int(v), 0x112, 0xf, 0xf, false));
    v += __int_as_float(__builtin_amdgcn_update_dpp(0, __float_as_int(v), 0x114, 0xf, 0xf, false));
    v += __int_as_float(__builtin_amdgcn_update_dpp(0, __float_as_int(v), 0x118, 0xf, 0xf, false));
    const float t0 = __int_as_float(__builtin_amdgcn_readlane(__float_as_int(v), 15)), t1 = __int_as_float(__builtin_amdgcn_readlane(__float_as_int(v), 31)), t2 = __int_as_float(__builtin_amdgcn_readlane(__float_as_int(v), 47));
    const int row = lane >> 4;
    return v + (row == 0 ? 0.f : row == 1 ? t0 : row == 2 ? (t0 + t1) : (t0 + t1 + t2));
}
__device__ __forceinline__ float wave_scan_max(float v, int lane) {
    const int ninf = __float_as_int(-3.0e38f);
    v = fmaxf(v, __int_as_float(__builtin_amdgcn_update_dpp(ninf, __float_as_int(v), 0x111, 0xf, 0xf, false)));
    v = fmaxf(v, __int_as_float(__builtin_amdgcn_update_dpp(ninf, __float_as_int(v), 0x112, 0xf, 0xf, false)));
    v = fmaxf(v, __int_as_float(__builtin_amdgcn_update_dpp(ninf, __float_as_int(v), 0x114, 0xf, 0xf, false)));
    v = fmaxf(v, __int_as_float(__builtin_amdgcn_update_dpp(ninf, __float_as_int(v), 0x118, 0xf, 0xf, false)));
    const float t0 = __int_as_float(__builtin_amdgcn_readlane(__float_as_int(v), 15)), t1 = __int_as_float(__builtin_amdgcn_readlane(__float_as_int(v), 31)), t2 = __int_as_float(__builtin_amdgcn_readlane(__float_as_int(v), 47));
    const int row = lane >> 4;
    return fmaxf(v, row == 0 ? -3.0e38f : row == 1 ? t0 : row == 2 ? fmaxf(t0, t1) : fmaxf(fmaxf(t0, t1), t2));
}
__device__ __forceinline__ float wave_sum(float v) {
#pragma unroll
    for (int o = 1; o < 64; o <<= 1) v += __shfl_xor(v, o);
    return v;
}

constexpr size_t MiB = 1u << 20;
constexpr size_t WS_CTL = 0;
constexpr size_t WS_BT1 = 1 * MiB, WS_WG = 6 * MiB, WS_WUQ = 10 * MiB, WS_WUKV = 10 * MiB + 512 * 1024, WS_WOA = 11 * MiB, WS_WOM = 12 * MiB,
                 WS_WOUT = 13 * MiB, WS_WFF = 15 * MiB, WS_WDN = 26 * MiB;
constexpr size_t WS_COS = 41 * MiB, WS_SIN = 43 * MiB, WS_RSQ = 45 * MiB, WS_RSKV = 45 * MiB + 512 * 1024, WS_RS2 = 46 * MiB, WS_GI = 47 * MiB,
                 WS_LF = 50 * MiB, WS_KR = 53 * MiB;
constexpr size_t WS_SSQQ = 46 * MiB + 512 * 1024;
constexpr size_t WS_R1 = 61 * MiB;
constexpr size_t WS_Q = 465 * MiB, WS_KV = 587 * MiB;
constexpr size_t WS_AO = 749 * MiB, WS_HF = 830 * MiB, WS_HB = 911 * MiB, WS_END = 992 * MiB;
static_assert(WS_R1 + (size_t)MP * ZW * 2 <= WS_Q && WS_Q + (size_t)MP * 768 * 2 <= WS_KV && WS_KV + (size_t)MP * 2048 <= WS_AO, "ws map");
static_assert(WS_AO + (size_t)MP * 1024 <= WS_HF && WS_HF + (size_t)MP * 1024 <= WS_HB && WS_HB + (size_t)MP * 1024 <= WS_END, "ws map 2");
static_assert(WS_R1 + (size_t)MP * DFF * 2 <= WS_KV && WS_AO + (size_t)MP * 2048 <= WS_HB, "ws map 3");

struct Params { const float* in[22]; float* out; unsigned char* ws; int ph_lo, ph_hi; };
enum { I_XP = 0, I_XS, I_META, I_NMIX, I_WIN, I_QN, I_WUQ, I_KVN, I_WUKV, I_BI, I_BF, I_MN, I_WOA, I_WOM, I_WOUT, I_NFFN, I_WUP, I_WGATE, I_CW, I_CB, I_WDN, I_NFIN };

__device__ __forceinline__ void row_info(int m, int& seq, int& l) { if (m < M_P) { seq = m / L_P; l = m - seq * L_P; } else { seq = 32; l = m - M_P; } }
__device__ __forceinline__ const float* hrow_ptr3(const float* xp, const float* xs, const float* meta, int m) {
    int seq, l; row_info(m, seq, l);
    if (l < NMETA) return meta + (size_t)l * DM;
    if (seq < 32) return xp + ((size_t)seq * S_P + (l - NMETA)) * DM;
    return xs + (size_t)(l - NMETA) * DM;
}
__device__ __forceinline__ const float* hrow_ptr(const Params& P, int m) { return hrow_ptr3(P.in[I_XP], P.in[I_XS], P.in[I_META], m); }

__device__ __forceinline__ void wt_item(const float* W, int ldw, int col0, int nvalid, int kvalid, int k0, const float* rs, float cs, bf16_t* dst, int K, LAS float* scr, int lane) {
#pragma unroll 8
    for (int i = 0; i < 32; ++i) {
        const int kk = 2 * i + (lane >> 5), n = lane & 31;
        float v = 0.f;
        if (n < nvalid && k0 + kk < kvalid) { v = W[(size_t)(k0 + kk) * ldw + col0 + n] * cs; if (rs) v *= rs[k0 + kk]; }
        scr[kk * 33 + n] = v;
    }
    asm volatile("s_waitcnt lgkmcnt(0)" ::: "memory");
    const int c = lane & 7;
#pragma unroll
    for (int j = 0; j < 4; ++j) {
        const int n = (lane >> 3) + 8 * j; const LAS float* s = scr + (8 * c) * 33 + n;
        u32x4 o; o.x = cvt_pk_bf16(s[0 * 33], s[1 * 33]); o.y = cvt_pk_bf16(s[2 * 33], s[3 * 33]); o.z = cvt_pk_bf16(s[4 * 33], s[5 * 33]); o.w = cvt_pk_bf16(s[6 * 33], s[7 * 33]);
        *(u32x4*)(dst + (size_t)n * K + k0 + 8 * c) = o;
    }
    asm volatile("s_waitcnt lgkmcnt(0)" ::: "memory");
}
struct WJob { int dst_off_mib_x2; int row0; int nrows; int K; int src; int ldw; int col0; int nvalid; int rs; int special; };
__device__ __forceinline__ void phase_prologue(const Params& P, LAS unsigned char* lds) {
    const int tid = threadIdx.x, lane = tid & 63, wid = tid >> 6;
    const int gw = blockIdx.x * 8 + wid, NGW = gridDim.x * 8;
    LAS float* scr = (LAS float*)(lds + wid * 16384);
    unsigned char* ws = P.ws;
    if (blockIdx.x == 0 && tid < 64) ((unsigned*)(ws + WS_CTL))[tid] = 0u;
    for (int i = blockIdx.x * 512 + tid; i < MP; i += gridDim.x * 512) { ((float*)(ws + WS_RS2))[i] = 0.f; ((float*)(ws + WS_RSQ))[i] = 0.f; ((float*)(ws + WS_RSKV))[i] = 0.f; ((float*)(ws + WS_SSQQ))[i] = 0.f; }
    constexpr int NJ = 14;
    static constexpr WJob jobs[NJ] = {
        {2, 0, 416, 1024, I_WIN, 4528, 0, 416, -1, 0},
        {2, 416, 32, 1024, I_WIN, 4528, 2464, 16, -1, 0},
        {2, 448, 64, 1024, I_WIN, 4528, 0, 0, -1, 0},
        {2, 512, 512, 1024, I_WIN, 4528, 416, 512, -1, 0},
        {2, 1024, 512, 1024, I_WIN, 4528, 928, 512, -1, 1},
        {2, 1536, 1024, 1024, I_WIN, 4528, 1440, 1024, -1, 0},
        {12, 0, 2048, 1024, I_WIN, 4528, 2480, 2048, -1, 0},
        {20, 0, 768, 256, I_WUQ, 768, 0, 768, I_QN, 4},
        {21, 0, 1024, 256, I_WUKV, 1024, 0, 1024, I_KVN, 3},
        {22, 0, 1024, 512, I_WOA, 1024, 0, 1024, -1, 0},
        {24, 0, 1024, 512, I_WOM, 1024, 0, 1024, -1, 0},
        {26, 0, 1024, 1024, I_WOUT, 1024, 0, 1024, -1, 0},
        {30, 0, 5632, 1024, I_WUP, 2816, 0, 5632, I_NFFN, 2},
        {52, 0, 1024, 2816, I_WDN, 1024, 0, 1024, -1, 0},
    };
    int total = 0;
#pragma unroll
    for (int j = 0; j < NJ; ++j) total += (jobs[j].nrows / 32) * (jobs[j].K / 64);
    for (int it = gw; it < total; it += NGW) {
        int r = it;
#pragma unroll
        for (int j = 0; j < NJ; ++j) {
            const int cnt = (jobs[j].nrows / 32) * (jobs[j].K / 64);
            if (r >= 0 && r < cnt) {
                const int nkb = jobs[j].K / 64, nb = r / nkb, kb = r % nkb;
                const float* src = P.in[jobs[j].src]; int col0 = jobs[j].col0 + 32 * nb; int nvalid = jobs[j].nvalid - 32 * nb; float cs = 1.f;
                int drow = jobs[j].row0 + 32 * nb;
                if (jobs[j].special == 1) cs = 0.08838834764831845f;
                if (jobs[j].special == 4) cs = QSCALE;
                if (jobs[j].special == 2) { const int pp = nb >> 3, within = nb & 7, half = within >> 2, cb = within & 3; src = half ? P.in[I_WGATE] : P.in[I_WUP]; col0 = 128 * pp + 32 * cb; nvalid = 32; }
                nvalid = nvalid < 0 ? 0 : (nvalid > 32 ? 32 : nvalid);
                bf16_t* dst = (bf16_t*)(ws + (size_t)jobs[j].dst_off_mib_x2 * (MiB / 2)) + (size_t)drow * jobs[j].K;
                wt_item(src, jobs[j].ldw, col0, nvalid, jobs[j].special == 3 ? 128 : jobs[j].K, 64 * kb, jobs[j].rs >= 0 ? P.in[jobs[j].rs] : nullptr, cs, dst, jobs[j].K, scr, lane);
            }
            r -= cnt;
        }
    }
    bf16_t* U = (bf16_t*)P.out;
    const float* gm = P.in[I_NMIX];
    for (int m0 = gw; m0 < MP; m0 += 2 * NGW) {
        f32x4 v[2][4]; float ss[2] = {0.f, 0.f}; bool ok[2];
#pragma unroll
        for (int h = 0; h < 2; ++h) {
            const int m = m0 + h * NGW; ok[h] = m < M_TOK;
            const f32x4* xr = (const f32x4*)hrow_ptr(P, ok[h] ? m : 0) + lane;
#pragma unroll
            for (int j = 0; j < 4; ++j) { v[h][j] = xr[64 * j]; ss[h] += (v[h][j].x * v[h][j].x + v[h][j].y * v[h][j].y) + (v[h][j].z * v[h][j].z + v[h][j].w * v[h][j].w); }
        }
#pragma unroll
        for (int h = 0; h < 2; ++h) {
            const int m = m0 + h * NGW; if (m >= MP) continue;
            unsigned long long* o8 = (unsigned long long*)(U + (size_t)m * DM) + lane;
            const float rstd = ok[h] ? rsqrt_(wave_sum(ss[h]) * (1.f / DM) + EPS) : 0.f;
#pragma unroll
            for (int j = 0; j < 4; ++j) {
                const f32x4 gg = ((const f32x4*)gm)[lane + 64 * j];
                o8[64 * j] = (unsigned long long)cvt_pk_bf16(v[h][j].x * rstd * gg.x, v[h][j].y * rstd * gg.y) | ((unsigned long long)cvt_pk_bf16(v[h][j].z * rstd * gg.z, v[h][j].w * rstd * gg.w) << 32);
            }
        }
    }
#ifdef MK_FILL
    {
        u32x4* fp = (u32x4*)(ws + 45 * MiB); const size_t nf = (size_t)(992 - 45) * MiB / 16;
        const u32x4 fv = {MK_FILL, MK_FILL, MK_FILL, MK_FILL};
        for (size_t i = (size_t)blockIdx.x * 512 + tid; i < nf; i += (size_t)gridDim.x * 512) fp[i] = fv;
    }
#endif
    float* cosT = (float*)(ws + WS_COS); float* sinT = (float*)(ws + WS_SIN);
    for (int i = blockIdx.x * 512 + tid; i < L_S * 16; i += gridDim.x * 512) {
        const int l = i >> 4, j = i & 15;
        const float q4 = (j & 3) == 0 ? 1.0f : (j & 3) == 1 ? 0.5623413251903491f : (j & 3) == 2 ? 0.31622776601683794f : 0.1778279410038923f;
        const float d4 = (j >> 2) == 0 ? 1.0f : (j >> 2) == 1 ? 0.1f : (j >> 2) == 2 ? 0.01f : 0.001f;
        const float inv = (float)((double)q4 * (double)d4);
        const float ang = (float)l * inv;
        const double x = (double)ang, k = rint(x * 0.15915494309189535);
        const float r = (float)fma(-k, 6.283185307179586, x);
        cosT[i] = cosf(r); sinT[i] = sinf(r);
    }
}

__device__ __forceinline__ void phase_rowsmall(const Params& P) {
    const int tid = threadIdx.x, lane = tid & 63, wid = tid >> 6;
    const int gw = blockIdx.x * 8 + wid, NGW = gridDim.x * 8;
    unsigned char* ws = P.ws;
    const bf16_t* Z1 = (const bf16_t*)(ws + WS_R1); bf16_t* Z1w = (bf16_t*)(ws + WS_R1);
    float* GI = (float*)(ws + WS_GI); float* LF = (float*)(ws + WS_LF); bf16_t* KR = (bf16_t*)(ws + WS_KR);
    const float* cosT = (const float*)(ws + WS_COS); const float* sinT = (const float*)(ws + WS_SIN);
    for (int m0 = gw; m0 < MP; m0 += 2 * NGW) {
        u32x2 av[2]; unsigned bv[2]; float s1v[2], s2v[2];
#pragma unroll
        for (int h = 0; h < 2; ++h) {
            const int m = (m0 + h * NGW) < MP ? (m0 + h * NGW) : m0;
            const bf16_t* z = Z1 + (size_t)m * ZW;
            av[h] = *(const u32x2*)(z + 4 * lane);
            bv[h] = *(const unsigned*)(z + 256 + 2 * lane);
        }
#pragma unroll
        for (int h = 0; h < 2; ++h) {
            const u32x2 a = av[h]; const unsigned b = bv[h];
            s1v[h] = bf_lo(a.x) * bf_lo(a.x) + bf_hi(a.x) * bf_hi(a.x) + bf_lo(a.y) * bf_lo(a.y) + bf_hi(a.y) * bf_hi(a.y);
            s2v[h] = bf_lo(b) * bf_lo(b) + bf_hi(b) * bf_hi(b);
        }
#pragma unroll
        for (int o = 1; o < 64; o <<= 1) { s1v[0] += __shfl_xor(s1v[0], o); s1v[1] += __shfl_xor(s1v[1], o); s2v[0] += __shfl_xor(s2v[0], o); s2v[1] += __shfl_xor(s2v[1], o); }
#pragma unroll
        for (int h = 0; h < 2; ++h) {
            const int m = m0 + h * NGW; if (m >= MP) continue;
            const bf16_t* z = Z1 + (size_t)m * ZW;
            const u32x2 a = av[h]; const unsigned b = bv[h];
            {
                const float r1 = rsqrt_(s1v[h] * (1.f / 256.f) + EPS), r2 = rsqrt_(s2v[h] * (1.f / 128.f) + EPS);
                u32x2 na; na.x = cvt_pk_bf16(bf_lo(a.x) * r1, bf_hi(a.x) * r1); na.y = cvt_pk_bf16(bf_lo(a.y) * r1, bf_hi(a.y) * r1);
                *(u32x2*)(Z1w + (size_t)m * ZW + 4 * lane) = na;
                *(unsigned*)(Z1w + (size_t)m * ZW + 256 + 2 * lane) = cvt_pk_bf16(bf_lo(b) * r2, bf_hi(b) * r2);
            }
            int seq, l; row_info(m < M_TOK ? m : M_TOK - 1, seq, l);
            if (lane < 16) {
                const float x1 = bf2f(z[384 + lane]), x2 = bf2f(z[400 + lane]);
                const float c = cosT[l * 16 + lane], sn = sinT[l * 16 + lane];
                KR[(size_t)m * 32 + lane] = f2bf(x1 * c - x2 * sn);
                KR[(size_t)m * 32 + 16 + lane] = f2bf(x1 * sn + x2 * c);
            } else if (lane < 24) {
                const int i = lane - 16;
                GI[(size_t)m * 8 + i] = bf2f(z[416 + i]) + P.in[I_BI][i];
            } else if (lane < 32) {
                const int i = lane - 24;
                const float x = bf2f(z[424 + i]) + P.in[I_BF][i];
                LF[(size_t)m * 8 + i] = fminf(x, 0.f) - log1pf(expf(-fabsf(x)));
            }
        }
    }
}

enum { EM_PLAIN = 0, EM_KV, EM_Q, EM_SIG, EM_MRGA, EM_MRGB, EM_RES1, EM_DOWN, EM_Z1 };
template <int MODE> struct EpiG {
    static constexpr bool PERM = true, AFTER_DRAIN = false;
    bf16_t* O; int ldc; const float* rs; const bf16_t* G; const float* cosT; const float* sinT; const float* xp; const float* xs; const float* meta; float* out; const float* aux0; const float* aux1;
    __device__ __forceinline__ void operator()(const pg8::f32x4 (&acc)[2][2][4][2], const pg8::Unit& u, int wr, int wc, int fr, int fq) const {
#pragma unroll
        for (int ai = 0; ai < 2; ++ai)
#pragma unroll
            for (int m = 0; m < 4; ++m) {
                const int row = u.pm * 256 + ai * 128 + wr * 64 + m * 16 + fr;
                float rsv = 1.f; if (MODE == EM_KV || MODE == EM_Q) rsv = rsqrt_(rs[row] * (MODE == EM_Q ? (1.f / 256.f) : (1.f / 128.f)) + EPS);
                int seq = 0, l = 0; const float* hp = nullptr; bool live = true; float ssq = 0.f;
                if (MODE == EM_RES1 || MODE == EM_Z1) { row_info(row < M_TOK ? row : M_TOK - 1, seq, l); }
                int hrow = row;
                if (MODE == EM_DOWN) { seq = row < NB_P * S_P ? (row >> 11) : 32; l = row - seq * S_P + NMETA; hrow = (seq < 32 ? seq * L_P : M_P) + l; }
                if (MODE == EM_RES1) { live = row < M_TOK; hp = hrow_ptr3(xp, xs, meta, row < M_TOK ? row : 0); }

#pragma unroll
                for (int bj = 0; bj < 2; ++bj) {
                    const int cbase = u.pn * 256 + bj * 128 + wc * 32;
                    const int col = cbase + 8 * fq;
                    f32x4 v0 = acc[ai][bj][m][0], v1 = acc[ai][bj][m][1];
                    if (MODE == EM_Z1) {
                        if (u.pn == 0 || (u.pn == 1 && bj == 0))
                            ssq += (v0[0] * v0[0] + v0[1] * v0[1]) + (v0[2] * v0[2] + v0[3] * v0[3]) + (v1[0] * v1[0] + v1[1] * v1[1]) + (v1[2] * v1[2] + v1[3] * v1[3]);
                        if (u.pn == 1 && bj == 1 && wc == 0) {
                            const int lz = l < L_S ? l : L_S - 1, j0 = 8 * (fq & 1);
                            const f32x4 c0 = *(const f32x4*)(cosT + lz * 16 + j0), c1 = *(const f32x4*)(cosT + lz * 16 + j0 + 4);
                            const f32x4 s0 = *(const f32x4*)(sinT + lz * 16 + j0), s1 = *(const f32x4*)(sinT + lz * 16 + j0 + 4);
                            f32x4 y0, y1;
#pragma unroll
                            for (int i = 0; i < 4; ++i) { y0[i] = __shfl_xor(v0[i], 32); y1[i] = __shfl_xor(v1[i], 32); }
                            const float sg = (fq < 2) ? -1.f : 1.f;
                            const f32x4 r0 = v0 * c0 + (y0 * s0) * sg, r1 = v1 * c1 + (y1 * s1) * sg;
                            u32x4 w; w.x = cvt_pk_bf16(r0[0], r0[1]); w.y = cvt_pk_bf16(r0[2], r0[3]); w.z = cvt_pk_bf16(r1[0], r1[1]); w.w = cvt_pk_bf16(r1[2], r1[3]);
                            *(u32x4*)(const_cast<bf16_t*>(G) + (size_t)row * 32 + 8 * fq) = w;
                        }
                        if (u.pn == 1 && bj == 1 && wc == 1 && fq < 2) {
                            const float* bb = fq == 0 ? aux0 : aux1;
                            float gv[8] = {v0[0] + bb[0], v0[1] + bb[1], v0[2] + bb[2], v0[3] + bb[3], v1[0] + bb[4], v1[1] + bb[5], v1[2] + bb[6], v1[3] + bb[7]};
                            if (fq == 1) {
#pragma unroll
                                for (int i = 0; i < 8; ++i) gv[i] = fminf(gv[i], 0.f) - log1pf(expf(-fabsf(gv[i])));
                            }
                            float* gp = const_cast<float*>(fq == 0 ? xs : meta) + (size_t)row * 8;
                            *(f32x4*)gp = (f32x4){gv[0], gv[1], gv[2], gv[3]}; *(f32x4*)(gp + 4) = (f32x4){gv[4], gv[5], gv[6], gv[7]};
                        }
                    }
                    if (MODE == EM_KV || MODE == EM_Q) { v0 = v0 * rsv; v1 = v1 * rsv; }
                    if (MODE == EM_SIG) {
#pragma unroll
                        for (int i = 0; i < 4; ++i) { v0[i] = sigmoidf_(v0[i]); v1[i] = sigmoidf_(v1[i]); }
                    }
                    if (MODE == EM_MRGA || MODE == EM_MRGB) {
                        const u32x4 gt = *(const u32x4*)(G + (size_t)row * ZW + (MODE == EM_MRGB ? 1024 : 0) + col);
                        v0[0] *= bf_lo(gt.x); v0[1] *= bf_hi(gt.x); v0[2] *= bf_lo(gt.y); v0[3] *= bf_hi(gt.y);
                        v1[0] *= bf_lo(gt.z); v1[1] *= bf_hi(gt.z); v1[2] *= bf_lo(gt.w); v1[3] *= bf_hi(gt.w);
                        if (MODE == EM_MRGB) {
                            const u32x4 y = *(const u32x4*)(O + (size_t)row * ldc + col);
                            v0[0] += bf_lo(y.x); v0[1] += bf_hi(y.x); v0[2] += bf_lo(y.y); v0[3] += bf_hi(y.y);
                            v1[0] += bf_lo(y.z); v1[1] += bf_hi(y.z); v1[2] += bf_lo(y.w); v1[3] += bf_hi(y.w);
                        }
                    }
                    if (MODE == EM_RES1) {
                        if (live) { const f32x4 h0 = *(const f32x4*)(hp + col), h1 = *(const f32x4*)(hp + col + 4); v0 = v0 + h0; v1 = v1 + h1; }
                        ssq += (v0[0] * v0[0] + v0[1] * v0[1]) + (v0[2] * v0[2] + v0[3] * v0[3]) + (v1[0] * v1[0] + v1[1] * v1[1]) + (v1[2] * v1[2] + v1[3] * v1[3]);
                    }
                    if (MODE == EM_DOWN) {
                        if (live) {
                            const u32x4 hb = *(const u32x4*)(G + (size_t)hrow * 1024 + col);
                            v0[0] += bf_lo(hb.x); v0[1] += bf_hi(hb.x); v0[2] += bf_lo(hb.y); v0[3] += bf_hi(hb.y);
                            v1[0] += bf_lo(hb.z); v1[1] += bf_hi(hb.z); v1[2] += bf_lo(hb.w); v1[3] += bf_hi(hb.w);
                            const_cast<pg8::f32x4&>(acc[ai][bj][m][0]) = v0; const_cast<pg8::f32x4&>(acc[ai][bj][m][1]) = v1;
                            ssq += (v0[0] * v0[0] + v0[1] * v0[1]) + (v0[2] * v0[2] + v0[3] * v0[3]) + (v1[0] * v1[0] + v1[1] * v1[1]) + (v1[2] * v1[2] + v1[3] * v1[3]);
                        }
                    } else {
                        if (live) {
                            u32x4 w; w.x = cvt_pk_bf16(v0[0], v0[1]); w.y = cvt_pk_bf16(v0[2], v0[3]); w.z = cvt_pk_bf16(v1[0], v1[1]); w.w = cvt_pk_bf16(v1[2], v1[3]);
                            *(u32x4*)(O + (size_t)row * ldc + col) = w;
                        }
                    }
                }
                if (MODE == EM_Z1) {
                    if (u.pn <= 1) { ssq = xsum_16_32(ssq); if (fq == 0) atomicAdd(const_cast<float*>(u.pn == 0 ? rs : xp) + row, ssq); }
                }
                if (MODE == EM_RES1 || MODE == EM_DOWN) {
                    ssq = xsum_16_32(ssq);
                    if (live && fq == 0) atomicAdd(const_cast<float*>(rs) + row, ssq);
                }
                if (MODE != EM_PLAIN && MODE != EM_SIG) asm volatile("" ::: "memory");
            }
        if (MODE == EM_DOWN) {
            unsigned* cnt = (unsigned*)const_cast<float*>(sinT) + u.pm;
            asm volatile("s_waitcnt vmcnt(0)" ::: "memory");
            __syncthreads();
            if (threadIdx.x == 0) {
                __builtin_amdgcn_fence(__ATOMIC_RELEASE, "agent");
                __hip_atomic_fetch_add(cnt, 1u, __ATOMIC_RELAXED, __HIP_MEMORY_SCOPE_AGENT);
                unsigned spins = 0;
                while (__hip_atomic_load(cnt, __ATOMIC_RELAXED, __HIP_MEMORY_SCOPE_AGENT) < 4u && ++spins < (1u << 17)) __builtin_amdgcn_s_sleep(1);
                __builtin_amdgcn_fence(__ATOMIC_ACQUIRE, "agent");
                asm volatile("s_waitcnt vmcnt(0)" ::: "memory");
            }
            __syncthreads();
#pragma unroll
            for (int ai = 0; ai < 2; ++ai)
#pragma unroll
                for (int m = 0; m < 4; ++m) {
                    const int row = u.pm * 256 + ai * 128 + wr * 64 + m * 16 + fr;
                    const float ss = __hip_atomic_load(const_cast<float*>(rs) + row, __ATOMIC_RELAXED, __HIP_MEMORY_SCOPE_AGENT);
                    const float rstd = rsqrt_(ss * (1.f / DM) + EPS);
#pragma unroll
                    for (int bj = 0; bj < 2; ++bj) {
                        const int col = u.pn * 256 + bj * 128 + wc * 32 + 8 * fq;
                        const f32x4 g0 = *(const f32x4*)(cosT + col), g1 = *(const f32x4*)(cosT + col + 4);
                        float* op = out + (size_t)row * DM + col;
                        *(f32x4*)op = acc[ai][bj][m][0] * rstd * g0; *(f32x4*)(op + 4) = acc[ai][bj][m][1] * rstd * g1;
                    }
                    asm volatile("" ::: "memory");
                }
        }
    }
};

struct EpiFfn {
    static constexpr bool PERM = true, AFTER_DRAIN = false;
    bf16_t* T; const float* rs2; const float* cw; const float* cb;
    __device__ __forceinline__ void operator()(const pg8::f32x4 (&acc)[2][2][4][2], const pg8::Unit& u, int wr, int wc, int fr, int fq) const {
        const int f0 = u.pn * 128 + wc * 32 + 8 * fq;
#pragma unroll
        for (int ai = 0; ai < 2; ++ai) {
            const int rbase = u.pm * 248 + 62 * (2 * ai + wr) - 1;
            float rsv[4]; int lpos[4], llen[4], orow[4];
#pragma unroll
            for (int m = 0; m < 4; ++m) {
                int gr = rbase + 16 * m + fr; gr = gr < 0 ? 0 : (gr >= M_TOK ? M_TOK - 1 : gr);
                rsv[m] = rsqrt_(rs2[gr] * (1.f / DM) + EPS); int seq; row_info(gr, seq, lpos[m]); llen[m] = seq < 32 ? L_P : L_S;
                orow[m] = (rbase + 16 * m + fr < M_TOK && lpos[m] >= NMETA) ? (seq < 32 ? seq * S_P : NB_P * S_P) + lpos[m] - NMETA : -1;
            }
#pragma unroll
            for (int n = 0; n < 2; ++n) {
                const f32x4 w0 = *(const f32x4*)(cw + f0 + 4 * n), w1 = *(const f32x4*)(cw + DFF + f0 + 4 * n), w2 = *(const f32x4*)(cw + 2 * DFF + f0 + 4 * n);
                const f32x4 bb = *(const f32x4*)(cb + f0 + 4 * n);
                const f32x4 zero4 = {0.f, 0.f, 0.f, 0.f};
                f32x4 upm = acc[ai][0][0][n] * rsv[0], tp_prev = zero4, tn_cur;
#pragma unroll
                for (int i = 0; i < 4; ++i) tn_cur[i] = row_next(upm[i]);
#pragma unroll
                for (int m = 0; m < 4; ++m) {
                    f32x4 tp_cur, up_next = zero4, tn_next = zero4;
#pragma unroll
                    for (int i = 0; i < 4; ++i) tp_cur[i] = row_prev(upm[i]);
                    if (m < 3) {
                        up_next = acc[ai][0][m < 3 ? m + 1 : 3][n] * rsv[m < 3 ? m + 1 : 3];
#pragma unroll
                        for (int i = 0; i < 4; ++i) tn_next[i] = row_next(up_next[i]);
                    }
                    f32x4 pv = (fr == 0) ? tp_prev : tp_cur;
                    f32x4 nv = (fr == 15) ? tn_next : tn_cur;
                    if (lpos[m] == 0) pv = zero4;
                    if (lpos[m] == llen[m] - 1) nv = zero4;
                    const f32x4 a = w0 * pv + w1 * upm + w2 * nv + bb;
                    const f32x4 gt = acc[ai][1][m][n] * rsv[m];
                    f32x4 t;
#pragma unroll
                    for (int i = 0; i < 4; ++i) {
                        const float x = a[i], z = 1.5957691216057308f * (x + 0.044715f * x * x * x);
                        t[i] = x * sigmoidf_(z) * gt[i];
                    }
                    const int rr = 16 * m + fr;
                    u32x2 ow; ow.x = cvt_pk_bf16(t[0], t[1]); ow.y = cvt_pk_bf16(t[2], t[3]);
                    if (rr >= 1 && rr <= 62 && orow[m] >= 0) *(u32x2*)(T + (size_t)orow[m] * DFF + f0 + 4 * n) = ow;
                    tp_prev = tp_cur; upm = up_next; tn_cur = tn_next;
                }
                asm volatile("" ::: "memory");
            }
        }
    }
};

constexpr int AT_KP = 104, AT_VP = 72, AT_KBUF = 64 * AT_KP * 2, AT_VBUF = 64 * AT_VP * 2, AT_VOFF = 2 * AT_KBUF;
template <int NQS> __device__ __forceinline__ void attn_unit(const Params& P, LAS unsigned char* L, int seq, int head, int qrow0, int nocomp = 0) {
    int tid_ = threadIdx.x; asm volatile("" : "+v"(tid_));
    const int tid = tid_, lane = tid & 63, wid = __builtin_amdgcn_readfirstlane(tid >> 6), g = lane >> 4, c16 = lane & 15;
    const int Lseq = seq < 32 ? L_P : L_S, sb = seq < 32 ? seq * L_P : M_P;
    const int NT = (Lseq + 63) >> 6;
    unsigned char* ws = P.ws;
    const bf16_t* Qg = (const bf16_t*)(ws + WS_Q); const bf16_t* KVg = (const bf16_t*)(ws + WS_KV); const bf16_t* KRg = (const bf16_t*)(ws + WS_KR);
    bf16_t* AO = (bf16_t*)(ws + WS_AO);
    const int skey = tid >> 3, sc = tid & 7;
    const int vpos = (skey & 32) | (((skey >> 2) & 3) << 3) | (((skey >> 4) & 1) << 2) | (skey & 3);
    const int vcol = ((((vpos >> 3) ^ sc) & 7) << 3) | (vpos & 7);
    const bf16_t* gk = KVg + (size_t)(sb + skey) * 1024 + head * 128 + 8 * sc;
    const bf16_t* gr = KRg + (size_t)(sb + skey) * 32 + 4 * sc;
    u32x4 rk, rv; u32x2 rr;
#define AT_LOAD(t) do { rk = *(const u32x4*)(gk + (size_t)(t) * 64 * 1024); rv = *(const u32x4*)(gk + 64 + (size_t)(t) * 64 * 1024); rr = *(const u32x2*)(gr + (size_t)(t) * 64 * 32); } while (0)
#define AT_STORE(buf) do { LAS unsigned char* kb_ = L + (buf) * AT_KBUF; LAS unsigned char* vb_ = L + 4 * AT_KBUF + (buf) * AT_VBUF; \
        *(LAS u32x4*)(kb_ + (skey * AT_KP + 8 * sc) * 2) = rk; *(LAS u32x2*)(kb_ + (skey * AT_KP + 64 + 4 * sc) * 2) = rr; \
        LAS bf16_t* vt_ = (LAS bf16_t*)vb_ + (8 * sc) * AT_VP + vcol; \
        vt_[0 * AT_VP] = (bf16_t)(rv.x & 0xffffu); vt_[1 * AT_VP] = (bf16_t)(rv.x >> 16); vt_[2 * AT_VP] = (bf16_t)(rv.y & 0xffffu); vt_[3 * AT_VP] = (bf16_t)(rv.y >> 16); \
        vt_[4 * AT_VP] = (bf16_t)(rv.z & 0xffffu); vt_[5 * AT_VP] = (bf16_t)(rv.z >> 16); vt_[6 * AT_VP] = (bf16_t)(rv.w & 0xffffu); vt_[7 * AT_VP] = (bf16_t)(rv.w >> 16); } while (0)
    const int q0 = qrow0 + wid * 16 * NQS;
    const bool active = (q0 < Lseq) && !nocomp;
    bf16x8 qf[NQS][3];
#pragma unroll
    for (int qs = 0; qs < NQS; ++qs) {
        int qr = q0 + 16 * qs + c16; qr = qr < Lseq ? qr : Lseq - 1;
#pragma unroll
        for (int ks = 0; ks < 3; ++ks) qf[qs][ks] = *(const bf16x8*)(Qg + (size_t)(sb + qr) * 768 + head * 96 + 32 * ks + 8 * g);
        {
            const u32x4 own = __builtin_bit_cast(u32x4, qf[qs][2]);
            u32x4 oth; oth.x = __shfl_xor(own.x, 32); oth.y = __shfl_xor(own.y, 32); oth.z = __shfl_xor(own.z, 32); oth.w = __shfl_xor(own.w, 32);
            const float* ct = (const float*)(ws + WS_COS) + qr * 16 + 8 * (g & 1); const float* sn = (const float*)(ws + WS_SIN) + qr * 16 + 8 * (g & 1);
            const f32x4 c0 = *(const f32x4*)ct, c1 = *(const f32x4*)(ct + 4), s0 = *(const f32x4*)sn, s1 = *(const f32x4*)(sn + 4);
            const float sg = (g < 2) ? -1.f : 1.f;
            u32x4 r;
            r.x = cvt_pk_bf16(bf_lo(own.x) * c0[0] + sg * bf_lo(oth.x) * s0[0], bf_hi(own.x) * c0[1] + sg * bf_hi(oth.x) * s0[1]);
            r.y = cvt_pk_bf16(bf_lo(own.y) * c0[2] + sg * bf_lo(oth.y) * s0[2], bf_hi(own.y) * c0[3] + sg * bf_hi(oth.y) * s0[3]);
            r.z = cvt_pk_bf16(bf_lo(own.z) * c1[0] + sg * bf_lo(oth.z) * s1[0], bf_hi(own.z) * c1[1] + sg * bf_hi(oth.z) * s1[1]);
            r.w = cvt_pk_bf16(bf_lo(own.w) * c1[2] + sg * bf_lo(oth.w) * s1[2], bf_hi(own.w) * c1[3] + sg * bf_hi(oth.w) * s1[3]);
            qf[qs][2] = __builtin_bit_cast(bf16x8, r);
        }
    }
    f32x4 o[4][NQS]; float mrun[NQS], lsum[NQS];
#pragma unroll
    for (int qs = 0; qs < NQS; ++qs) { mrun[qs] = 0.f; lsum[qs] = 0.f;
#pragma unroll
        for (int dt = 0; dt < 4; ++dt) o[dt][qs] = (f32x4){0.f, 0.f, 0.f, 0.f}; }
    AT_LOAD(0); AT_STORE(0); AT_LOAD(1); AT_STORE(1);
    __syncthreads();
    for (int t = 0; t < NT; ++t) {
        const int buf = t & 3;
        const LAS unsigned char* kb = L + buf * AT_KBUF; const LAS unsigned char* vb = L + 4 * AT_KBUF + buf * AT_VBUF;
        f32x4 st[4][NQS];
        if (t + 2 < NT) AT_LOAD(t + 2);
        if (active) {
#pragma unroll
            for (int kt = 0; kt < 4; ++kt) {
#pragma unroll
                for (int qs = 0; qs < NQS; ++qs) { const float nm = -mrun[qs]; st[kt][qs] = (f32x4){nm, nm, nm, nm}; }
#pragma unroll
                for (int ks = 0; ks < 3; ++ks) {
                    const bf16x8 kf = *(const LAS bf16x8*)(kb + ((16 * kt + c16) * AT_KP + 32 * ks + 8 * g) * 2);
#pragma unroll
                    for (int qs = 0; qs < NQS; ++qs) st[kt][qs] = MFMA16(kf, qf[qs][ks], st[kt][qs]);
                }
                if (kt == 1) __builtin_amdgcn_sched_barrier(0);
            }
        }
        if (active) {
            if (t == NT - 1) {
#pragma unroll
                for (int kt = 0; kt < 4; ++kt)
#pragma unroll
                    for (int r = 0; r < 4; ++r) if (64 * t + 16 * kt + 4 * g + r >= Lseq) {
#pragma unroll
                        for (int qs = 0; qs < NQS; ++qs) st[kt][qs][r] = -INFINITY; }
            }
            bf16x8 pb[NQS][2]; float psv[NQS];
            if (t == 0) {
#pragma unroll
                for (int qs = 0; qs < NQS; ++qs) {
                    float mx = fmaxf(fmaxf(st[0][qs][0], st[0][qs][1]), fmaxf(st[0][qs][2], st[0][qs][3]));
#pragma unroll
                    for (int kt = 1; kt < 4; ++kt) mx = fmaxf(mx, fmaxf(fmaxf(st[kt][qs][0], st[kt][qs][1]), fmaxf(st[kt][qs][2], st[kt][qs][3])));
                    mx = xmax_16_32(mx);
                    mrun[qs] = mx;
#pragma unroll
                    for (int kt = 0; kt < 4; ++kt) st[kt][qs] = st[kt][qs] - mx;
                }
                asm volatile("" ::: "memory");
            }
#pragma unroll
            for (int qs = 0; qs < NQS; ++qs) {
                float ps = 0.f;
#pragma unroll
                for (int kt = 0; kt < 4; ++kt)
#pragma unroll
                    for (int r = 0; r < 4; ++r) { const float pv = __builtin_amdgcn_exp2f(st[kt][qs][r]); st[kt][qs][r] = pv; ps += pv; }
                lsum[qs] += ps; psv[qs] = ps;
#pragma unroll
                for (int k2 = 0; k2 < 2; ++k2) {
                    u32x4 w; w.x = cvt_pk_bf16(st[2 * k2][qs][0], st[2 * k2][qs][1]); w.y = cvt_pk_bf16(st[2 * k2][qs][2], st[2 * k2][qs][3]);
                    w.z = cvt_pk_bf16(st[2 * k2 + 1][qs][0], st[2 * k2 + 1][qs][1]); w.w = cvt_pk_bf16(st[2 * k2 + 1][qs][2], st[2 * k2 + 1][qs][3]);
                    pb[qs][k2] = __builtin_bit_cast(bf16x8, w);
                }
            }
#pragma unroll
            for (int dt = 0; dt < 4; ++dt)
#pragma unroll
                for (int k2 = 0; k2 < 2; ++k2) {
                    const int drow = 16 * dt + c16;
                    const bf16x8 vf = *(const LAS bf16x8*)(vb + (drow * AT_VP + ((((4 * k2 + g) ^ (drow >> 3)) & 7) << 3)) * 2);
#pragma unroll
                    for (int qs = 0; qs < NQS; ++qs) o[dt][qs] = MFMA16(vf, pb[qs][k2], o[dt][qs]);
                }
            {
                bool big = false;
#pragma unroll
                for (int qs = 0; qs < NQS; ++qs) big = big || (psv[qs] > 65536.0f);
                if (__any(big)) {
#pragma unroll
                    for (int qs = 0; qs < NQS; ++qs) {
                        const float rs = xsum_16_32(psv[qs]);
                        const float dl = rs > 65536.0f ? floorf(__builtin_amdgcn_logf(rs)) : 0.f;
                        const float alpha = __builtin_amdgcn_exp2f(-dl);
                        mrun[qs] += dl; lsum[qs] *= alpha;
#pragma unroll
                        for (int dt = 0; dt < 4; ++dt) o[dt][qs] = o[dt][qs] * alpha;
                    }
                }
            }
        }
        if (t + 2 < NT) AT_STORE((t + 2) & 3);
        if (t & 1) __syncthreads();
    }
    __syncthreads();
    if (active) {
#pragma unroll
        for (int qs = 0; qs < NQS; ++qs) {
            const float ls = xsum_16_32(lsum[qs]);
            const float inv = __builtin_amdgcn_rcpf(ls);
            const int qr = q0 + 16 * qs + c16;
            if (qr < Lseq) {
#pragma unroll
                for (int dt = 0; dt < 4; ++dt) {
                    u32x2 w; w.x = cvt_pk_bf16(o[dt][qs][0] * inv, o[dt][qs][1] * inv); w.y = cvt_pk_bf16(o[dt][qs][2] * inv, o[dt][qs][3] * inv);
                    *(u32x2*)(AO + (size_t)(sb + qr) * 512 + head * 64 + 16 * dt + 4 * g) = w;
                }
            }
        }
    }
#undef AT_LOAD
#undef AT_STORE
}

__device__ __forceinline__ void attn_unit_p(const Params& P, LAS unsigned char* L, int seq, int head, int qrow0) {
    constexpr int NQS = 2;
    int tid_ = threadIdx.x; asm volatile("" : "+v"(tid_));
    const int tid = tid_, lane = tid & 63, wid = __builtin_amdgcn_readfirstlane(tid >> 6), g = lane >> 4, c16 = lane & 15;
    const int Lseq = seq < 32 ? L_P : L_S, sb = seq < 32 ? seq * L_P : M_P;
    const int NT = (Lseq + 63) >> 6;
    unsigned char* ws = P.ws;
    const bf16_t* Qg = (const bf16_t*)(ws + WS_Q); const bf16_t* KVg = (const bf16_t*)(ws + WS_KV); const bf16_t* KRg = (const bf16_t*)(ws + WS_KR);
    bf16_t* AO = (bf16_t*)(ws + WS_AO);
    const int skey = tid >> 3, sc = tid & 7;
    const int vpos = (skey & 32) | (((skey >> 2) & 3) << 3) | (((skey >> 4) & 1) << 2) | (skey & 3);
    const int vcol = ((((vpos >> 3) ^ sc) & 7) << 3) | (vpos & 7);
    const bf16_t* gk = KVg + (size_t)(sb + skey) * 1024 + head * 128 + 8 * sc;
    const bf16_t* gr = KRg + (size_t)(sb + skey) * 32 + 4 * sc;
    u32x4 rkA, rvA, rkB, rvB; u32x2 rrA, rrB;
#define AP_LOADK(X, t) do { rk##X = *(const u32x4*)(gk + (size_t)(t) * 64 * 1024); rr##X = *(const u32x2*)(gr + (size_t)(t) * 64 * 32); } while (0)
#define AP_LOADV(X, t) do { rv##X = *(const u32x4*)(gk + 64 + (size_t)(t) * 64 * 1024); } while (0)
#define AP_STOREK(X, slot) do { LAS unsigned char* kb_ = L + (slot) * AT_KBUF; *(LAS u32x4*)(kb_ + (skey * AT_KP + 8 * sc) * 2) = rk##X; *(LAS u32x2*)(kb_ + (skey * AT_KP + 64 + 4 * sc) * 2) = rr##X; } while (0)
#define AP_STOREV(X, slot) do { const u32x4 rv = rv##X; LAS bf16_t* vt_ = (LAS bf16_t*)(L + AT_VOFF + (slot) * AT_VBUF) + (8 * sc) * AT_VP + vcol; \
        vt_[0 * AT_VP] = (bf16_t)(rv.x & 0xffffu); vt_[1 * AT_VP] = (bf16_t)(rv.x >> 16); vt_[2 * AT_VP] = (bf16_t)(rv.y & 0xffffu); vt_[3 * AT_VP] = (bf16_t)(rv.y >> 16); \
        vt_[4 * AT_VP] = (bf16_t)(rv.z & 0xffffu); vt_[5 * AT_VP] = (bf16_t)(rv.z >> 16); vt_[6 * AT_VP] = (bf16_t)(rv.w & 0xffffu); vt_[7 * AT_VP] = (bf16_t)(rv.w >> 16); } while (0)
    const int q0 = qrow0 + wid * 16 * NQS;
    const bool active = q0 < Lseq;
    bf16x8 qf[NQS][3];
#pragma unroll
    for (int qs = 0; qs < NQS; ++qs) {
        int qr = q0 + 16 * qs + c16; qr = qr < Lseq ? qr : Lseq - 1;
#pragma unroll
        for (int ks = 0; ks < 3; ++ks) qf[qs][ks] = *(const bf16x8*)(Qg + (size_t)(sb + qr) * 768 + head * 96 + 32 * ks + 8 * g);
        {
            const u32x4 own = __builtin_bit_cast(u32x4, qf[qs][2]);
            u32x4 oth; oth.x = __shfl_xor(own.x, 32); oth.y = __shfl_xor(own.y, 32); oth.z = __shfl_xor(own.z, 32); oth.w = __shfl_xor(own.w, 32);
            const float* ct = (const float*)(ws + WS_COS) + qr * 16 + 8 * (g & 1); const float* sn = (const float*)(ws + WS_SIN) + qr * 16 + 8 * (g & 1);
            const f32x4 c0 = *(const f32x4*)ct, c1 = *(const f32x4*)(ct + 4), s0 = *(const f32x4*)sn, s1 = *(const f32x4*)(sn + 4);
            const float sg = (g < 2) ? -1.f : 1.f;
            u32x4 r;
            r.x = cvt_pk_bf16(bf_lo(own.x) * c0[0] + sg * bf_lo(oth.x) * s0[0], bf_hi(own.x) * c0[1] + sg * bf_hi(oth.x) * s0[1]);
            r.y = cvt_pk_bf16(bf_lo(own.y) * c0[2] + sg * bf_lo(oth.y) * s0[2], bf_hi(own.y) * c0[3] + sg * bf_hi(oth.y) * s0[3]);
            r.z = cvt_pk_bf16(bf_lo(own.z) * c1[0] + sg * bf_lo(oth.z) * s1[0], bf_hi(own.z) * c1[1] + sg * bf_hi(oth.z) * s1[1]);
            r.w = cvt_pk_bf16(bf_lo(own.w) * c1[2] + sg * bf_lo(oth.w) * s1[2], bf_hi(own.w) * c1[3] + sg * bf_hi(oth.w) * s1[3]);
            qf[qs][2] = __builtin_bit_cast(bf16x8, r);
        }
    }
    f32x4 o[4][NQS]; float mrun[NQS], lsum[NQS], mxs[NQS], psv[NQS];
#pragma unroll
    for (int qs = 0; qs < NQS; ++qs) { mrun[qs] = 0.f; lsum[qs] = 0.f; mxs[qs] = 0.f; psv[qs] = 0.f;
#pragma unroll
        for (int dt = 0; dt < 4; ++dt) o[dt][qs] = (f32x4){0.f, 0.f, 0.f, 0.f}; }
    f32x4 stA[4][NQS], stB[4][NQS]; bf16x8 pb[NQS][2];
#define AP_QK(S, tt) do { const LAS unsigned char* kb = L + ((tt) & 1) * AT_KBUF; \
        _Pragma("unroll") for (int kt = 0; kt < 4; ++kt) { \
            _Pragma("unroll") for (int qs = 0; qs < NQS; ++qs) { const float nm = -mrun[qs]; S[kt][qs] = (f32x4){nm, nm, nm, nm}; } \
            _Pragma("unroll") for (int ks = 0; ks < 3; ++ks) { \
                const bf16x8 kf = *(const LAS bf16x8*)(kb + ((16 * kt + c16) * AT_KP + 32 * ks + 8 * g) * 2); \
                _Pragma("unroll") for (int qs = 0; qs < NQS; ++qs) S[kt][qs] = MFMA16(kf, qf[qs][ks], S[kt][qs]); } } \
        if ((tt) == NT - 1) { \
            _Pragma("unroll") for (int kt = 0; kt < 4; ++kt) _Pragma("unroll") for (int r = 0; r < 4; ++r) if (64 * (tt) + 16 * kt + 4 * g + r >= Lseq) { \
                _Pragma("unroll") for (int qs = 0; qs < NQS; ++qs) S[kt][qs][r] = -INFINITY; } } } while (0)
#define AP_ROWMAX(S) do { _Pragma("unroll") for (int qs = 0; qs < NQS; ++qs) { \
            float mx = fmaxf(fmaxf(S[0][qs][0], S[0][qs][1]), fmaxf(S[0][qs][2], S[0][qs][3])); \
            _Pragma("unroll") for (int kt = 1; kt < 4; ++kt) mx = fmaxf(mx, fmaxf(fmaxf(S[kt][qs][0], S[kt][qs][1]), fmaxf(S[kt][qs][2], S[kt][qs][3]))); \
            mxs[qs] = xmax_16_32(mx); } } while (0)
#define AP_GROW(S, tt) do { bool grow = ((tt) == 0); \
        _Pragma("unroll") for (int qs = 0; qs < NQS; ++qs) grow = grow || (mxs[qs] > 8.0f); \
        if (__any(grow)) { \
            _Pragma("unroll") for (int qs = 0; qs < NQS; ++qs) { \
                const float dl = ((tt) == 0) ? mxs[qs] : fmaxf(mxs[qs], 0.f); \
                const float alpha = __builtin_amdgcn_exp2f(-dl); \
                mrun[qs] += dl; lsum[qs] *= alpha; \
                _Pragma("unroll") for (int kt = 0; kt < 4; ++kt) S[kt][qs] = S[kt][qs] - dl; \
                _Pragma("unroll") for (int dt = 0; dt < 4; ++dt) o[dt][qs] = o[dt][qs] * alpha; } } } while (0)
#define AP_EXP(S) do { _Pragma("unroll") for (int qs = 0; qs < NQS; ++qs) { \
            float ps = 0.f; \
            _Pragma("unroll") for (int kt = 0; kt < 4; ++kt) _Pragma("unroll") for (int r = 0; r < 4; ++r) { const float pv = __builtin_amdgcn_exp2f(S[kt][qs][r]); S[kt][qs][r] = pv; ps += pv; } \
            lsum[qs] += ps; psv[qs] = ps; \
            _Pragma("unroll") for (int k2 = 0; k2 < 2; ++k2) { \
                u32x4 w; w.x = cvt_pk_bf16(S[2 * k2][qs][0], S[2 * k2][qs][1]); w.y = cvt_pk_bf16(S[2 * k2][qs][2], S[2 * k2][qs][3]); \
                w.z = cvt_pk_bf16(S[2 * k2 + 1][qs][0], S[2 * k2 + 1][qs][1]); w.w = cvt_pk_bf16(S[2 * k2 + 1][qs][2], S[2 * k2 + 1][qs][3]); \
                pb[qs][k2] = __builtin_bit_cast(bf16x8, w); } } } while (0)
#define AP_PV(tt) do { const LAS unsigned char* vb = L + AT_VOFF + ((tt) & 1) * AT_VBUF; \
        _Pragma("unroll") for (int dt = 0; dt < 4; ++dt) _Pragma("unroll") for (int k2 = 0; k2 < 2; ++k2) { \
            const int drow = 16 * dt + c16; \
            const bf16x8 vf = *(const LAS bf16x8*)(vb + (drow * AT_VP + ((((4 * k2 + g) ^ (drow >> 3)) & 7) << 3)) * 2); \
            _Pragma("unroll") for (int qs = 0; qs < NQS; ++qs) o[dt][qs] = MFMA16(vf, pb[qs][k2], o[dt][qs]); } } while (0)
#define AP_LAZY(NXT) do { bool big = false; \
        _Pragma("unroll") for (int qs = 0; qs < NQS; ++qs) big = big || (psv[qs] > 65536.0f); \
        if (__any(big)) { \
            _Pragma("unroll") for (int qs = 0; qs < NQS; ++qs) { \
                const float rs = xsum_16_32(psv[qs]); \
                const float dl = rs > 65536.0f ? floorf(__builtin_amdgcn_logf(rs)) : 0.f; \
                const float alpha = __builtin_amdgcn_exp2f(-dl); \
                mrun[qs] += dl; lsum[qs] *= alpha; \
                _Pragma("unroll") for (int kt = 0; kt < 4; ++kt) NXT[kt][qs] = NXT[kt][qs] - dl; \
                _Pragma("unroll") for (int dt = 0; dt < 4; ++dt) o[dt][qs] = o[dt][qs] * alpha; } } } while (0)
#define AP_STEP(CUR, NXT, LD, ST, t) do { \
        if ((t) + 3 < NT) AP_LOADK(LD, (t) + 3); \
        if ((t) + 2 < NT) AP_LOADV(LD, (t) + 2); \
        if (active) { \
            if ((t) + 1 < NT) { AP_QK(NXT, (t) + 1); } \
            AP_EXP(CUR); \
            AP_PV(t); \
            if ((t) + 1 < NT) { AP_LAZY(NXT); } \
        } \
        if ((t) + 2 < NT) AP_STOREK(ST, (t) & 1); \
        if ((t) + 1 < NT) AP_STOREV(ST, ((t) + 1) & 1); \
        __syncthreads(); } while (0)
    AP_LOADK(A, 0); AP_LOADV(A, 0); AP_STOREK(A, 0); AP_STOREV(A, 0);
    AP_LOADK(A, 1); AP_STOREK(A, 1);
    AP_LOADK(B, 2); AP_LOADV(B, 1);
    __syncthreads();
    if (active) { AP_QK(stA, 0); AP_ROWMAX(stA);
#pragma unroll
        for (int qs = 0; qs < NQS; ++qs) { mrun[qs] = mxs[qs];
#pragma unroll
            for (int kt = 0; kt < 4; ++kt) stA[kt][qs] = stA[kt][qs] - mxs[qs]; } }
    __syncthreads();
    int t = 0;
    for (; t + 1 < NT; t += 2) { AP_STEP(stA, stB, A, B, t); AP_STEP(stB, stA, B, A, t + 1); }
    if (t < NT) { AP_STEP(stA, stB, A, B, t); }
    if (active) {
#pragma unroll
        for (int qs = 0; qs < NQS; ++qs) {
            const float ls = xsum_16_32(lsum[qs]);
            const float inv = __builtin_amdgcn_rcpf(ls);
            const int qr = q0 + 16 * qs + c16;
            if (qr < Lseq) {
#pragma unroll
                for (int dt = 0; dt < 4; ++dt) {
                    u32x2 w; w.x = cvt_pk_bf16(o[dt][qs][0] * inv, o[dt][qs][1] * inv); w.y = cvt_pk_bf16(o[dt][qs][2] * inv, o[dt][qs][3] * inv);
                    *(u32x2*)(AO + (size_t)(sb + qr) * 512 + head * 64 + 16 * dt + 4 * g) = w;
                }
            }
        }
    }
#undef AP_LOADK
#undef AP_LOADV
#undef AP_STOREK
#undef AP_STOREV
#undef AP_QK
#undef AP_ROWMAX
#undef AP_GROW
#undef AP_LAZY
#undef AP_EXP
#undef AP_PV
#undef AP_STEP
}

constexpr int ML_QP = 136, ML_SP = 72;
constexpr int ML_QS = 0, ML_KS = 64 * ML_QP * 2, ML_KWT = ML_KS + 64 * ML_QP * 2, ML_VT = ML_KWT + 128 * ML_SP * 2, ML_CB = ML_VT + 144 * ML_SP * 2,
              ML_SB = ML_CB + 144 * ML_QP * 2, ML_DEN = ML_SB + 64 * ML_SP * 2, ML_END = ML_DEN + 256;
static_assert(ML_END <= 131072, "mlstm lds");
__device__ __forceinline__ void mlstm_unit(const Params& P, LAS unsigned char* L, int seq, int hd, int dir) {
    int tid_ = threadIdx.x; asm volatile("" : "+v"(tid_));
    const int tid = tid_, lane = tid & 63, wid = __builtin_amdgcn_readfirstlane(tid >> 6), g = lane >> 4, c16 = lane & 15;
    const int Lseq = seq < 32 ? L_P : L_S, sb = seq < 32 ? seq * L_P : M_P;
    const int NC = (Lseq + 48) >> 6;
    unsigned char* ws = P.ws;
    const bf16_t* Z1 = (const bf16_t*)(ws + WS_R1);
    const float* GI = (const float*)(ws + WS_GI); const float* LF = (const float*)(ws + WS_LF);
    bf16_t* HP = (bf16_t*)(ws + (dir ? WS_HB : WS_HF));
    LAS bf16_t* Qs = (LAS bf16_t*)(L + ML_QS); LAS bf16_t* Ks = (LAS bf16_t*)(L + ML_KS); LAS bf16_t* KwT = (LAS bf16_t*)(L + ML_KWT);
    LAS bf16_t* VT = (LAS bf16_t*)(L + ML_VT); LAS bf16_t* Cb = (LAS bf16_t*)(L + ML_CB); LAS bf16_t* Sb = (LAS bf16_t*)(L + ML_SB);
    LAS float* DEN = (LAS float*)(L + ML_DEN);
    for (int i = tid; i < 16 * ML_SP; i += 512) VT[128 * ML_SP + i] = (i < 64) ? (bf16_t)0x3F80 : (bf16_t)0;
    for (int i = tid; i < 144 * ML_QP / 2; i += 512) ((LAS unsigned*)Cb)[i] = 0u;
    f32x4 Cacc[9];
#pragma unroll
    for (int e = 0; e < 9; ++e) Cacc[e] = (f32x4){0.f, 0.f, 0.f, 0.f};
    float mstate = -1e30f;
    const int sj = tid >> 4, scx = tid & 15, d0 = 8 * scx;
    u32x4 pq[2], pk[2], pv[2]; float pgi, plf;
#define ML_TOK(c_, j_) (dir ? (64 * (c_) + 15 - (j_)) : (64 * (c_) - 48 + (j_)))
#define ML_PREFETCH(step_) do { const int c_ = dir ? (NC - 1 - (step_)) : (step_); \
        { const int l_ = ML_TOK(c_, lane); const size_t r_ = (size_t)(sb + (l_ >= 0 ? l_ : 0)); pgi = l_ >= 0 ? GI[r_ * 8 + dir * 4 + hd] : -1e30f; plf = l_ >= 0 ? LF[r_ * 8 + dir * 4 + hd] : 0.f; } \
        _Pragma("unroll") for (int i2 = 0; i2 < 2; ++i2) { const int l_ = ML_TOK(c_, sj + 32 * i2); \
            const bf16_t* zp_ = Z1 + (size_t)(sb + (l_ >= 0 ? l_ : 0)) * ZW + 512 + hd * 128 + d0; \
            if (l_ >= 0) { pq[i2] = *(const u32x4*)zp_; pk[i2] = *(const u32x4*)(zp_ + 512); pv[i2] = *(const u32x4*)(zp_ + 1024); } \
            else { pq[i2] = (u32x4){0u, 0u, 0u, 0u}; pk[i2] = pq[i2]; pv[i2] = pq[i2]; } } } while (0)
    ML_PREFETCH(0);
    __syncthreads();
    f32x4 a1[4], a2[4]; float Mt_o = 0.f, b_o = 0.f, ms_o = 0.f; int ls_o = -1;
    const int swzw = (2 * wid + (c16 >> 3)) & 7;
#define ML_OUTPUT() do { _Pragma("unroll") for (int tt = 0; tt < 4; ++tt) { \
            const int tl = 16 * tt + c16; \
            const float Mt_t = __shfl(Mt_o, tl), b_t = __shfl(b_o, tl); \
            const int l_t = __shfl(ls_o, tl); \
            const float et = __expf(ms_o - Mt_t), fl = __expf(-(b_t + Mt_t)); \
            const float den = DEN[tl]; \
            const float inv = __builtin_amdgcn_rcpf(fmaxf(fabsf(den), fl)); \
            if (l_t >= 0) { \
                u32x2 w; w.x = cvt_pk_bf16((a1[tt][0] + et * a2[tt][0]) * inv, (a1[tt][1] + et * a2[tt][1]) * inv); \
                w.y = cvt_pk_bf16((a1[tt][2] + et * a2[tt][2]) * inv, (a1[tt][3] + et * a2[tt][3]) * inv); \
                *(u32x2*)(HP + (size_t)(sb + l_t) * 512 + hd * 128 + 16 * wid + 4 * g) = w; } } } while (0)
    for (int step = 0; step < NC; ++step) {
        const int c = dir ? (NC - 1 - step) : step;
        const int ls = ML_TOK(c, lane);
        const float gi = pgi, lf = plf;
        const float b = wave_scan_sum(lf, lane);
        const float gtot = __int_as_float(__builtin_amdgcn_readlane(__float_as_int(b), 63));
        const float uu = gi - b;
        const float pm = wave_scan_max(uu, lane);
        const float pm63 = __int_as_float(__builtin_amdgcn_readlane(__float_as_int(pm), 63));
        const float mloc = gtot + pm63;
        const float Mt = fmaxf(pm, mstate);
        const float mnew = fmaxf(gtot + mstate, mloc);
        const float sp = __expf(gtot + mstate - mnew), sl = __expf(mloc - mnew);
        const float wsl = __expf(uu - pm63) * sl;
        if (step > 0) ML_OUTPUT();
#pragma unroll
        for (int i2 = 0; i2 < 2; ++i2) {
            const int j = sj + 32 * i2;
            const float wj = __shfl(wsl, j);
            *(LAS u32x4*)(Qs + j * ML_QP + d0) = pq[i2];
            *(LAS u32x4*)(Ks + j * ML_QP + d0) = pk[i2];
            const int col = ((((j >> 3) ^ scx) & 7) << 3) | (j & 7);
            LAS bf16_t* kw = KwT + d0 * ML_SP + col; LAS bf16_t* vt = VT + d0 * ML_SP + col;
            const unsigned kk[4] = {pk[i2].x, pk[i2].y, pk[i2].z, pk[i2].w}, vv[4] = {pv[i2].x, pv[i2].y, pv[i2].z, pv[i2].w};
#pragma unroll
            for (int e = 0; e < 4; ++e) {
                const unsigned pkd = cvt_pk_bf16(bf_lo(kk[e]) * wj, bf_hi(kk[e]) * wj);
                kw[(2 * e) * ML_SP] = (bf16_t)(pkd & 0xffffu); kw[(2 * e + 1) * ML_SP] = (bf16_t)(pkd >> 16);
                vt[(2 * e) * ML_SP] = (bf16_t)(vv[e] & 0xffffu); vt[(2 * e + 1) * ML_SP] = (bf16_t)(vv[e] >> 16);
            }
        }
        if (step + 1 < NC) ML_PREFETCH(step + 1);
        __syncthreads();
        {
            const int tt = wid >> 1;
            const float Mt_t = __shfl(Mt, 16 * tt + c16);
#pragma unroll
            for (int sti = 0; sti < 2; ++sti) {
                const int stile = 2 * (wid & 1) + sti;
                f32x4 a = {0.f, 0.f, 0.f, 0.f};
                if (stile <= tt) {
#pragma unroll
                    for (int ks = 0; ks < 4; ++ks) {
                        const bf16x8 kf = *(const LAS bf16x8*)(Ks + (16 * stile + c16) * ML_QP + 32 * ks + 8 * g);
                        const bf16x8 qf = *(const LAS bf16x8*)(Qs + (16 * tt + c16) * ML_QP + 32 * ks + 8 * g);
                        a = MFMA16(kf, qf, a);
                    }
                }
                float vals[4];
#pragma unroll
                for (int r = 0; r < 4; ++r) {
                    const int si = 16 * stile + 4 * g + r;
                    const float us = __shfl(uu, si);
                    vals[r] = (si <= 16 * tt + c16) ? a[r] * __expf(us - Mt_t) : 0.f;
                }
                u32x2 w; w.x = cvt_pk_bf16(vals[0], vals[1]); w.y = cvt_pk_bf16(vals[2], vals[3]);
                *(LAS u32x2*)(Sb + (16 * tt + c16) * ML_SP + 16 * stile + 4 * g) = w;
            }
        }
#pragma unroll
        for (int tt = 0; tt < 4; ++tt) {
            a2[tt] = (f32x4){0.f, 0.f, 0.f, 0.f};
#pragma unroll
            for (int ks = 0; ks < 4; ++ks) {
                const bf16x8 cf = *(const LAS bf16x8*)(Cb + (16 * wid + c16) * ML_QP + 32 * ks + 8 * g);
                const bf16x8 qf = *(const LAS bf16x8*)(Qs + (16 * tt + c16) * ML_QP + 32 * ks + 8 * g);
                a2[tt] = MFMA16(cf, qf, a2[tt]);
            }
        }
        f32x4 d2 = {0.f, 0.f, 0.f, 0.f};
        if (wid < 4) {
#pragma unroll
            for (int ks = 0; ks < 4; ++ks) {
                const bf16x8 cf = *(const LAS bf16x8*)(Cb + (128 + c16) * ML_QP + 32 * ks + 8 * g);
                const bf16x8 qf = *(const LAS bf16x8*)(Qs + (16 * wid + c16) * ML_QP + 32 * ks + 8 * g);
                d2 = MFMA16(cf, qf, d2);
            }
        }
        __syncthreads();
#pragma unroll
        for (int tt = 0; tt < 4; ++tt) {
            a1[tt] = (f32x4){0.f, 0.f, 0.f, 0.f};
#pragma unroll
            for (int k2 = 0; k2 < 2; ++k2) {
                const bf16x8 vf = *(const LAS bf16x8*)(VT + (16 * wid + c16) * ML_SP + (((4 * k2 + g) ^ swzw) << 3));
                const bf16x8 sf = *(const LAS bf16x8*)(Sb + (16 * tt + c16) * ML_SP + 32 * k2 + 8 * g);
                a1[tt] = MFMA16(vf, sf, a1[tt]);
            }
        }
        if (wid < 4) {
            f32x4 d1 = {0.f, 0.f, 0.f, 0.f};
#pragma unroll
            for (int k2 = 0; k2 < 2; ++k2) {
                const bf16x8 vf = *(const LAS bf16x8*)(VT + (128 + c16) * ML_SP + (((4 * k2 + g) ^ (c16 >> 3)) << 3));
                const bf16x8 sf = *(const LAS bf16x8*)(Sb + (16 * wid + c16) * ML_SP + 32 * k2 + 8 * g);
                d1 = MFMA16(vf, sf, d1);
            }
            const float et = __expf(mstate - __shfl(Mt, 16 * wid + c16));
            if (g == 0) DEN[16 * wid + c16] = d1[0] + et * d2[0];
        }
        {
            bf16x8 kf[2];
#pragma unroll
            for (int k2 = 0; k2 < 2; ++k2) kf[k2] = *(const LAS bf16x8*)(KwT + (16 * wid + c16) * ML_SP + (((4 * k2 + g) ^ swzw) << 3));
#pragma unroll
            for (int et = 0; et < 9; ++et) {
                f32x4 cc = Cacc[et] * sp;
                const int swze = (2 * et + (c16 >> 3)) & 7;
#pragma unroll
                for (int k2 = 0; k2 < 2; ++k2) {
                    const bf16x8 vf = *(const LAS bf16x8*)(VT + (16 * et + c16) * ML_SP + (((4 * k2 + g) ^ swze) << 3));
                    cc = MFMA16(kf[k2], vf, cc);
                }
                Cacc[et] = cc;
                u32x2 w; w.x = cvt_pk_bf16(cc[0], cc[1]); w.y = cvt_pk_bf16(cc[2], cc[3]);
                *(LAS u32x2*)(Cb + (16 * et + c16) * ML_QP + 16 * wid + 4 * g) = w;
            }
        }
        Mt_o = Mt; b_o = b; ls_o = ls; ms_o = mstate;
        mstate = mnew;
        __syncthreads();
    }
    ML_OUTPUT();
    __syncthreads();
#undef ML_OUTPUT
#undef ML_TOK
#undef ML_PREFETCH
}

#ifndef ATT_PIPE
#define ATT_PIPE 0
#endif
#if ATT_PIPE
constexpr int Q_SML = 8, Q_PML = 256, Q_ML = Q_SML + Q_PML, Q_SAT = 8 * 65, Q_PAT = 32 * 8 * 9, Q_PRM = 0, Q_AT = Q_SAT + Q_PAT;
#else
constexpr int Q_SML = 8, Q_PML = 256, Q_ML = Q_SML + Q_PML, Q_SAT = 8 * 43, Q_PAT = 32 * 8 * 5, Q_PRM = 256, Q_AT = Q_SAT + Q_PAT + Q_PRM;
#endif
__device__ __forceinline__ void phase_mixers(const Params& P, LAS unsigned char* lds, int rep, int pflag) {
    LAS int* qw = (LAS int*)(lds + 131072);
    unsigned* ctr = (unsigned*)(P.ws + WS_CTL) + 2 * rep;
    if (!(pflag & 2)) for (;;) {
        if (threadIdx.x == 0) qw[0] = (int)atomicAdd(ctr, 1u);
        __syncthreads();
        int idx = __builtin_amdgcn_readfirstlane(qw[0]);
        __syncthreads();
        if (idx >= Q_ML) break;
        if (idx < Q_SML) { mlstm_unit(P, lds, 32, idx >> 1, idx & 1); continue; } idx -= Q_SML;
        mlstm_unit(P, lds, idx >> 3, (idx >> 1) & 3, idx & 1);
    }
    if (!(pflag & 1)) {
        const int myx = (int)(__builtin_amdgcn_s_getreg((3 << 11) | 20) & 7u);
        for (;;) {
            if (threadIdx.x == 0) {
                int sel = -1;
                for (int k = 0; k < 8; ++k) {
                    const int x = (myx + k) & 7;
                    const int j = (int)atomicAdd(ctr + 16 + x, 1u);
                    if (j < 43 + 32 * 6) { sel = x * 1024 + j; break; }
                }
                qw[0] = sel;
            }
            __syncthreads();
            const int sel = __builtin_amdgcn_readfirstlane(qw[0]);
            __syncthreads();
            if (sel < 0) break;
            const int hh = sel >> 10; int j = sel & 1023;
            int sq, r0;
            if (j < 43) { sq = 32; r0 = j * 384; }
            else { j -= 43; sq = j / 6; const int uu = j % 6; r0 = uu < 5 ? uu * 384 : 1920; }
            attn_unit<3>(P, lds, sq, hh, r0, pflag & 4);
        }
    }
}

__device__ __forceinline__ void phase_hm_final(const Params& P, LAS unsigned char* lds) {
    const int tid = threadIdx.x, lane = tid & 63, wid = tid >> 6;
    const int gw = blockIdx.x * 8 + wid, NGW = gridDim.x * 8;
    unsigned char* ws = P.ws;
    bf16_t* HF = (bf16_t*)(ws + WS_HF); const bf16_t* HB = (const bf16_t*)(ws + WS_HB); const bf16_t* Z1 = (const bf16_t*)(ws + WS_R1);
    const float* mn = P.in[I_MN];
    const f32x4 g0 = *(const f32x4*)(mn + 8 * lane), g1 = *(const f32x4*)(mn + 8 * lane + 4);
    const float gg[8] = {g0.x, g0.y, g0.z, g0.w, g1.x, g1.y, g1.z, g1.w};
    LAS int* qw = (LAS int*)(lds + 131072);
    unsigned* ctr = (unsigned*)(ws + WS_CTL) + 4;
    for (;;) {
      if (tid == 0) qw[0] = (int)atomicAdd(ctr, 1u);
      __syncthreads();
      const int ch = __builtin_amdgcn_readfirstlane(qw[0]);
      __syncthreads();
      if (ch >= MP / 64) break;
      for (int it = 0; it < 4; ++it) {
        const int m0 = ch * 64 + wid * 8 + 2 * it; const int NGW1 = 1;
        u32x4 av[2], bv[2], ov[2];
#pragma unroll
        for (int h = 0; h < 2; ++h) {
            int m = m0 + h * NGW1; m = m < M_TOK ? m : 0;
            av[h] = *(const u32x4*)(HF + (size_t)m * 512 + 8 * lane); bv[h] = *(const u32x4*)(HB + (size_t)m * 512 + 8 * lane); ov[h] = *(const u32x4*)(Z1 + (size_t)m * ZW + 2048 + 8 * lane);
        }
#pragma unroll
        for (int h = 0; h < 2; ++h) {
            const int m = m0 + h * NGW1; if (m >= MP) continue;
            u32x4* hp = (u32x4*)(HF + (size_t)m * 512 + 8 * lane);
            if (m >= M_TOK) { *hp = (u32x4){0u, 0u, 0u, 0u}; continue; }
            const u32x4 a = av[h], b = bv[h], o = ov[h];
            float v[8] = {bf_lo(a.x) + bf_lo(b.x), bf_hi(a.x) + bf_hi(b.x), bf_lo(a.y) + bf_lo(b.y), bf_hi(a.y) + bf_hi(b.y),
                          bf_lo(a.z) + bf_lo(b.z), bf_hi(a.z) + bf_hi(b.z), bf_lo(a.w) + bf_lo(b.w), bf_hi(a.w) + bf_hi(b.w)};
            const float og[8] = {bf_lo(o.x), bf_hi(o.x), bf_lo(o.y), bf_hi(o.y), bf_lo(o.z), bf_hi(o.z), bf_lo(o.w), bf_hi(o.w)};
            float sq = 0.f;
#pragma unroll
            for (int i = 0; i < 8; ++i) sq += v[i] * v[i];
            sq += __shfl_xor(sq, 1); sq += __shfl_xor(sq, 2); sq += __shfl_xor(sq, 4); sq += __shfl_xor(sq, 8);
            const float rstd = rsqrt_(sq * (1.f / 128.f) + EPS);
#pragma unroll
            for (int i = 0; i < 8; ++i) v[i] = v[i] * rstd * gg[i] * sigmoidf_(og[i]);
            u32x4 w; w.x = cvt_pk_bf16(v[0], v[1]); w.y = cvt_pk_bf16(v[2], v[3]); w.z = cvt_pk_bf16(v[4], v[5]); w.w = cvt_pk_bf16(v[6], v[7]);
            *hp = w;
        }
      }
    }
}
__device__ __forceinline__ void phase_rstd2(const Params& P) {
    const int tid = threadIdx.x, lane = tid & 63, wid = tid >> 6;
    const int gw = blockIdx.x * 8 + wid, NGW = gridDim.x * 8;
    const bf16_t* H1 = (const bf16_t*)(P.ws + WS_AO); float* rs2 = (float*)(P.ws + WS_RS2);
    for (int m = gw; m < M_TOK; m += NGW) {
        const u32x4 a = *(const u32x4*)(H1 + (size_t)m * DM + 8 * lane), b = *(const u32x4*)(H1 + (size_t)m * DM + 512 + 8 * lane);
        float s = bf_lo(a.x) * bf_lo(a.x) + bf_hi(a.x) * bf_hi(a.x) + bf_lo(a.y) * bf_lo(a.y) + bf_hi(a.y) * bf_hi(a.y) + bf_lo(a.z) * bf_lo(a.z) + bf_hi(a.z) * bf_hi(a.z) + bf_lo(a.w) * bf_lo(a.w) + bf_hi(a.w) * bf_hi(a.w);
        s += bf_lo(b.x) * bf_lo(b.x) + bf_hi(b.x) * bf_hi(b.x) + bf_lo(b.y) * bf_lo(b.y) + bf_hi(b.y) * bf_hi(b.y) + bf_lo(b.z) * bf_lo(b.z) + bf_hi(b.z) * bf_hi(b.z) + bf_lo(b.w) * bf_lo(b.w) + bf_hi(b.w) * bf_hi(b.w);
        s = wave_sum(s);
        if (lane == 0) rs2[m] = 1.0f / sqrtf(s * (1.f / DM) + EPS);
    }
}
__device__ __forceinline__ void phase_final_norm(const Params& P) {
    const float* gf = P.in[I_NFIN]; const float* ssq = (const float*)(P.ws + WS_RSQ);
    const size_t n4 = (size_t)(NB_P * S_P + 16384) * (DM / 4);
    for (size_t i = (size_t)blockIdx.x * 512 + threadIdx.x; i < n4; i += (size_t)gridDim.x * 512) {
        const int row = (int)(i >> 8), c4 = (int)(i & 255);
        const float rstd = 1.0f / sqrtf(ssq[row] * (1.f / DM) + EPS);
        const u32x2 hw = ((const u32x2*)(P.ws + WS_KV))[i];
        const f32x4 hv = {bf_lo(hw.x), bf_hi(hw.x), bf_lo(hw.y), bf_hi(hw.y)};
        ((f32x4*)P.out)[i] = hv * rstd * ((const f32x4*)gf)[c4];
    }
}

#define XB_TMO      128
#define XB_XCNT(j)  (256  + 64 * (j))
#define XB_XSUB(j)  (1280 + 64 * (j))
#define XB_XGEN(j)  (2304 + 64 * (j))
#define XB_TOP      3328
#define XB_TOPGEN   3392
#define XCD_BAR_WORDS 3456
#define XB_SPIN_CAP (1u << 18)

__device__ __forceinline__ unsigned xb_ld(unsigned* p)              { return __hip_atomic_load(p, __ATOMIC_RELAXED, __HIP_MEMORY_SCOPE_AGENT); }
__device__ __forceinline__ unsigned xb_add(unsigned* p, unsigned v) { return __hip_atomic_fetch_add(p, v, __ATOMIC_RELAXED, __HIP_MEMORY_SCOPE_AGENT); }
__device__ __forceinline__ unsigned xb_xcc_id() { return (unsigned)__builtin_amdgcn_s_getreg((3 << 11) | 20) & 0xFu; }
#define XB_SPIN(cond, bar) do { unsigned _sp = 0; while (cond) { __builtin_amdgcn_s_sleep(1); \
    if ((++_sp & 255u) == 0u) { if (xb_ld(&(bar)[XB_TMO])) break; if (_sp > XB_SPIN_CAP) { atomicAdd(&(bar)[XB_TMO], 1u); break; } } } } while (0)

struct XcdBarrier {
    unsigned* bar; unsigned x;
    volatile LAS unsigned* st;
};

__device__ __forceinline__ XcdBarrier xcd_barrier_post(unsigned* bar, volatile LAS unsigned* st) {
    XcdBarrier b; b.bar = bar; b.x = xb_xcc_id(); b.st = st;
    if (threadIdx.x == 0) (void)xb_add(&bar[XB_XCNT(b.x)], 1u);
    return b;
}
__device__ __forceinline__ void xcd_barrier_complete(unsigned* bar, unsigned x, unsigned& nloc, unsigned& nx) {
    const unsigned G = gridDim.x * gridDim.y * gridDim.z;
    unsigned sum, cnt, mine, sp = 0u;
    for (;;) {
        sum = 0u; cnt = 0u; mine = 0u;
#pragma unroll
        for (unsigned j = 0; j < 16; ++j) { const unsigned c = xb_ld(&bar[XB_XCNT(j)]); sum += c; cnt += (c > 0u) ? 1u : 0u; mine = (j == x) ? c : mine; }
        if (sum == G) break;
        __builtin_amdgcn_s_sleep(1);
        if ((++sp & 255u) == 0u) { if (xb_ld(&bar[XB_TMO])) break; if (sp > XB_SPIN_CAP) { atomicAdd(&bar[XB_TMO], 1u); break; } }
    }
    nloc = mine > 0u ? mine : 1u; nx = cnt > 0u ? cnt : 1u;
}

__device__ __forceinline__ void xcd_barrier(const XcdBarrier& b) {
    asm volatile("s_waitcnt vmcnt(0)" ::: "memory");
    __syncthreads();
    if (threadIdx.x == 0) {
        unsigned* bar = b.bar;
        __builtin_amdgcn_s_waitcnt(0);
        unsigned nloc = b.st[0], nx = b.st[1];
        if (nloc == 0u) { xcd_barrier_complete(bar, b.x, nloc, nx); b.st[0] = nloc; b.st[1] = nx; }
        const unsigned old = xb_add(&bar[XB_XSUB(b.x)], 1u);
        const unsigned gen = old / nloc;
        if (old + 1u == (gen + 1u) * nloc) {
            __builtin_amdgcn_fence(__ATOMIC_RELEASE, "agent");
            asm volatile("s_waitcnt vmcnt(0)" ::: "memory");
            const unsigned og = xb_add(&bar[XB_TOP], 1u);
            const unsigned tg = og / nx;
            if (og + 1u == (tg + 1u) * nx) xb_add(&bar[XB_TOPGEN], 1u);
            else XB_SPIN(xb_ld(&bar[XB_TOPGEN]) == tg, bar);
            __builtin_amdgcn_fence(__ATOMIC_ACQUIRE, "agent");
            xb_add(&bar[XB_XGEN(b.x)], 1u);
            asm volatile("s_waitcnt vmcnt(0)" ::: "memory");
        } else {
            XB_SPIN(xb_ld(&bar[XB_XGEN(b.x)]) == gen, bar);
            __builtin_amdgcn_fence(__ATOMIC_ACQUIRE, "agent");
            asm volatile("s_waitcnt vmcnt(0)" ::: "memory");
        }
    }
    __syncthreads();
}

#ifndef GEMM_SP2
#define GEMM_SP2 true
#endif
constexpr int LDS_BYTES = 139264;
constexpr int N_PHASES = 13;
template <int MODE> __device__ __forceinline__ void run_gemm(LAS unsigned char* lds, const bf16_t* A, int lda, const bf16_t* Bt, int Mrows, int N, int K, const EpiG<MODE>& E) {
    pg8::Gemm g{A, Bt, Mrows, N, K, lda, 0}; pg8::StaticOrder S; S.init(Mrows, N, (int)gridDim.x, (int)blockIdx.x);
    pg8::gemm_phase<EpiG<MODE>, pg8::StaticOrder, true, GEMM_SP2>(lds, g, S, E);
}
__global__ void __launch_bounds__(512, 2) mk_fwd(Params P) {
    extern __shared__ __attribute__((aligned(16))) unsigned char lds_raw[];
    LAS unsigned char* lds = (LAS unsigned char*)lds_raw;
    unsigned char* ws = P.ws;
    const int lo = P.ph_lo, hi = P.ph_hi & 0xff, pflag = P.ph_hi >> 8;
#ifndef PHM
#define PHM 0xFFFF
#endif
#define IN(k) (((PHM >> (k)) & 1) && lo <= (k) && (k) < hi)
#if MK_MULTI_LAUNCH
#define SEAM(k) do { } while (0)
#else
#define SEAM(k) do { if (IN(k) && IN((k) + 1)) { if ((k) == 0) { asm volatile("s_waitcnt vmcnt(0)" ::: "memory"); cg::this_grid().sync(); } else { xcd_barrier(xbar); } } } while (0)
#endif
    const float* cosT = (const float*)(ws + WS_COS); const float* sinT = (const float*)(ws + WS_SIN);
    bf16_t* Z1 = (bf16_t*)(ws + WS_R1); bf16_t* U = (bf16_t*)P.out;
#if !MK_MULTI_LAUNCH
    if (threadIdx.x == 0) { ((volatile LAS unsigned*)(lds + 131072 + 64))[0] = 0u; ((volatile LAS unsigned*)(lds + 131072 + 64))[1] = 0u; }
    __syncthreads();
    const XcdBarrier xbar = xcd_barrier_post((unsigned*)(ws + WS_CTL) + 4096, (volatile LAS unsigned*)(lds + 131072 + 64));
#endif
    if (IN(0)) { phase_prologue(P, lds); } SEAM(0);
    if (IN(1)) { EpiG<EM_Z1> E{Z1, ZW, (const float*)(ws + WS_SSQQ), (const bf16_t*)(ws + WS_KR), cosT, sinT, (const float*)(ws + WS_RSKV), (const float*)(ws + WS_GI), (const float*)(ws + WS_LF), P.out, P.in[I_BI], P.in[I_BF]};
        run_gemm<EM_Z1>(lds, U, DM, (const bf16_t*)(ws + WS_BT1), MP, ZW, DM, E); } SEAM(1);
    if (IN(3)) {
        { EpiG<EM_Q> E{(bf16_t*)(ws + WS_Q), 768, (const float*)(ws + WS_SSQQ), nullptr, nullptr, nullptr, P.in[I_XP], P.in[I_XS], P.in[I_META], P.out}; run_gemm<EM_Q>(lds, Z1, ZW, (const bf16_t*)(ws + WS_WUQ), MP, 768, 256, E); }
        { EpiG<EM_KV> E{(bf16_t*)(ws + WS_KV), 1024, (const float*)(ws + WS_RSKV), nullptr, nullptr, nullptr, P.in[I_XP], P.in[I_XS], P.in[I_META], P.out}; run_gemm<EM_KV>(lds, Z1 + 256, ZW, (const bf16_t*)(ws + WS_WUKV), MP, 1024, 256, E); }
    } SEAM(3);
    if (IN(4)) { phase_mixers(P, lds, 0, pflag); } SEAM(4);
    if (IN(6)) { EpiG<EM_SIG> E{Z1, ZW, nullptr, nullptr, nullptr, nullptr, P.in[I_XP], P.in[I_XS], P.in[I_META], P.out}; run_gemm<EM_SIG>(lds, U, DM, (const bf16_t*)(ws + WS_WG), MP, 2048, DM, E); }
    if (IN(5)) { phase_hm_final(P, lds); }
    SEAM(6);
    bf16_t* Y = (bf16_t*)(ws + WS_KV);
    if (IN(7)) { EpiG<EM_MRGA> E{Y, DM, nullptr, Z1, nullptr, nullptr, P.in[I_XP], P.in[I_XS], P.in[I_META], P.out}; run_gemm<EM_MRGA>(lds, (const bf16_t*)(ws + WS_AO), 512, (const bf16_t*)(ws + WS_WOA), MP, DM, 512, E); }
    if (IN(8)) { EpiG<EM_MRGB> E{Y, DM, nullptr, Z1, nullptr, nullptr, P.in[I_XP], P.in[I_XS], P.in[I_META], P.out}; run_gemm<EM_MRGB>(lds, (const bf16_t*)(ws + WS_HF), 512, (const bf16_t*)(ws + WS_WOM), MP, DM, 512, E); } SEAM(8);
    bf16_t* H1 = (bf16_t*)(ws + WS_AO);
    if (IN(9)) { EpiG<EM_RES1> E{H1, DM, (const float*)(ws + WS_RS2), nullptr, nullptr, nullptr, P.in[I_XP], P.in[I_XS], P.in[I_META], P.out}; run_gemm<EM_RES1>(lds, Y, DM, (const bf16_t*)(ws + WS_WOUT), MP, DM, DM, E); } SEAM(9);
    bf16_t* T = (bf16_t*)(ws + WS_R1);
    if (IN(11)) {
        EpiFfn E{T, (const float*)(ws + WS_RS2), P.in[I_CW], P.in[I_CB]};
        pg8::Gemm g{H1 - DM, (const bf16_t*)(ws + WS_WFF), 333 * 256, 2 * DFF, DM, DM, 1}; pg8::StaticOrder S; S.init(333 * 256, 2 * DFF, (int)gridDim.x, (int)blockIdx.x);
        pg8::gemm_phase<EpiFfn, pg8::StaticOrder, true, GEMM_SP2>(lds, g, S, E);
    } SEAM(11);
    if (IN(12)) { EpiG<EM_DOWN> E{Y, DM, (const float*)(ws + WS_RSQ), H1, P.in[I_NFIN], (const float*)((const unsigned*)(ws + WS_CTL) + 8192), P.in[I_XP], P.in[I_XS], P.in[I_META], P.out}; run_gemm<EM_DOWN>(lds, T, DFF, (const bf16_t*)(ws + WS_WDN), NB_P * S_P + 16384, DM, DFF, E); } SEAM(12);
#undef IN
#undef SEAM
}

extern "C" void kernel_launch(void* const* d_in, const int* in_sizes, int n_in, void* d_out, int out_size, void* d_ws, size_t ws_size, hipStream_t stream) {
    static int grid = 0;
    if (grid == 0) {
        if (n_in != 22 || ws_size < WS_END) { fprintf(stderr, "kernel_launch: unexpected n_in %d or ws_size %zu (< %zu)\n", n_in, ws_size, (size_t)WS_END); grid = -1; return; }
        int dev = 0, cus = 0, per_cu = 0;
        (void)hipGetDevice(&dev); (void)hipDeviceGetAttribute(&cus, hipDeviceAttributeMultiprocessorCount, dev);
        if (hipFuncSetAttribute((const void*)mk_fwd, hipFuncAttributeMaxDynamicSharedMemorySize, LDS_BYTES) != hipSuccess) { fprintf(stderr, "kernel_launch: hipFuncSetAttribute failed\n"); grid = -1; return; }
        if (hipOccupancyMaxActiveBlocksPerMultiprocessor(&per_cu, (const void*)mk_fwd, 512, LDS_BYTES) != hipSuccess || per_cu < 1) { fprintf(stderr, "kernel_launch: occupancy query failed (%d)\n", per_cu); per_cu = 1; }
        (void)hipGetLastError();
        grid = cus * (per_cu > 1 ? 1 : per_cu);
        if (grid <= 0) grid = 256;
    }
    if (grid < 0) return;
    Params p{};
    for (int i = 0; i < 22; ++i) p.in[i] = (const float*)d_in[i];
    p.out = (float*)d_out; p.ws = (unsigned char*)d_ws;
#if MK_MULTI_LAUNCH
#ifndef DUPM
#define DUPM 0
#endif
#ifndef P4FLAG
#define P4FLAG 0
#endif
    for (int ph = 0; ph <= N_PHASES; ++ph) {
        p.ph_lo = ph; p.ph_hi = ph + 1;
        for (int rep = 0; rep < (((DUPM >> ph) & 1) ? 2 : 1); ++rep) {
            if (ph == 4 && rep > 0) { (void)hipMemsetAsync((char*)d_ws + WS_CTL, 0, 256, stream); p.ph_hi = (ph + 1) | (P4FLAG << 8); }
            hipLaunchKernelGGL(mk_fwd, dim3(grid), dim3(512), LDS_BYTES, stream, p);
        }
    }
#else
    p.ph_lo = 0; p.ph_hi = N_PHASES + 1;
    (void)hipMemsetAsync((char*)d_ws + WS_CTL, 0, 65536, stream);
    void* args[] = {&p};
    hipError_t e = hipLaunchCooperativeKernel((const void*)mk_fwd, dim3(grid), dim3(512), args, LDS_BYTES, stream);
    if (e != hipSuccess) fprintf(stderr, "cooperative launch failed: %s (grid %d)\n", hipGetErrorString(e), grid);
#endif
}
```

```cpp
#include <hip/hip_runtime.h>
#include <hip/hip_cooperative_groups.h>
#include <cstdio>
#include <cstdint>
#include <cmath>
namespace cg = cooperative_groups;

#ifndef MK_MULTI_LAUNCH
#define MK_MULTI_LAUNCH 0
#endif

constexpr int DM = 1024, NB_P = 32, S_P = 2048, L_P = 2064, L_S = 16400, NMETA = 16;
constexpr int M_P = NB_P * L_P;
constexpr int M_TOK = M_P + L_S;
constexpr int MP = 82688;
constexpr int NSEQ = 33;
constexpr int ZW = 2560;
constexpr int DFF = 2816;
constexpr float EPS = 1e-6f;
constexpr float QSCALE = 0.10206207261596577f * 1.4426950408889634f;

namespace pg8 {
#define PG8_LAS __attribute__((address_space(3)))
typedef unsigned short bf16_t;
typedef short bf16x8 __attribute__((ext_vector_type(8)));
typedef float f32x4 __attribute__((ext_vector_type(4)));
typedef unsigned u32x4 __attribute__((ext_vector_type(4)));
constexpr int BM = 256, BK = 64, HALF = 128, HTB = HALF * BK * 2  , STAGE_BYTES = 8 * HTB, NXCD = 8, WGM = 8;

__host__ __device__ __forceinline__ int lds_byte(int r, int c) { const int st = (r >> 4) * 2 + (c >> 5), rr = r & 15, cc = c & 31, ob = rr * 64 + cc * 2; return st * 1024 + (ob ^ (((ob >> 9) & 1) << 5)); }
__host__ __device__ __forceinline__ void stage_rc(int b, int& R, int& C) { const int st = b / 1024, sb = b % 1024, swz = sb ^ (((sb >> 9) & 1) << 5); R = (st >> 1) * 16 + swz / 64; C = (st & 1) * 32 + (swz % 64) / 2; }
__host__ __device__ __forceinline__ int perm32(int rho) { const int n = rho >> 4, i = rho & 15; return 8 * (i >> 2) + 4 * n + (i & 3); }

struct Unit { int pm, pn; };
struct Gemm { const bf16_t* A; const bf16_t* Bt; int M, N, K, lda, ovl; };

struct StaticOrder {
    int nM, nN, nwg, G, c;
    __host__ __device__ void init(int M, int N, int G_, int c_) { nM = M / BM; nN = N / BM; nwg = nM * nN; G = G_; c = c_; }
    __host__ __device__ bool next(int i, Unit& u) const {
        const long L = (long)i * G + c; if (L >= nwg) return false;
        int wgid = (int)L; { const int q = nwg / NXCD, r = nwg % NXCD, xcd = wgid % NXCD, off = wgid / NXCD; wgid = (xcd < r ? xcd * (q + 1) : r * (q + 1) + (xcd - r) * q) + off; }
        const int nig = WGM * nN, gid = wgid / nig, fm = gid * WGM, gsz = (nM - fm) < WGM ? (nM - fm) : WGM;
        u.pm = fm + ((wgid % nig) % gsz); u.pn = (wgid % nig) / gsz; return true;
    }
    __device__ __forceinline__ void a_ready(const Unit&) const {}
    __device__ __forceinline__ void done(const Unit&) const {}
};

__device__ __forceinline__ unsigned cvt_pk_bf16(float lo, float hi) { unsigned r; asm volatile("v_cvt_pk_bf16_f32 %0, %1, %2" : "=v"(r) : "v"(lo), "v"(hi)); return r; }
template <class Epi, class Sched, bool ALIGN_EPI = false, bool SP2 = false>
__device__ __forceinline__ void gemm_phase(PG8_LAS unsigned char* lds, const Gemm g, const Sched& S, const Epi& E) {
    int tid_ = threadIdx.x; asm volatile("" : "+v"(tid_));
    const int tid = tid_, wid = __builtin_amdgcn_readfirstlane(tid >> 6), lane = tid & 63, wr = wid >> 2, wc = wid & 3, fr = lane & 15, fq = lane >> 4;
    const int K = g.K, nt = K / BK;
    unsigned voffA[2], voffB[2];
#pragma unroll
    for (int i = 0; i < 2; ++i) { int R, C; stage_rc(tid * 16 + i * 8192, R, C); const int Rb = Epi::PERM ? ((R & ~31) + perm32(R & 31)) : R;
        const int Ra = g.ovl ? (R - 2 * (R >> 6)) : R; voffA[i] = (unsigned)(Ra * g.lda + C) * 2u; voffB[i] = (unsigned)(Rb * K + C) * 2u; }
    const size_t kstep = (size_t)(BK * 2);
    const size_t hstepB = (size_t)HALF * K * 2, hstepA = (size_t)(g.ovl ? 124 : 128) * g.lda * 2;
    const size_t tstepB = 2 * hstepB, tstepA = 2 * hstepA;
    const unsigned ldsw = (unsigned)wid * 1024u;
    const int aoff = lds_byte(wr * 64 + fr, fq * 8), boff = lds_byte(wc * 32 + fr, fq * 8);
#define PG8_SA(b, h) (((b) * 2 + (h)) * HTB)
#define PG8_SB(b, h) ((4 + (b) * 2 + (h)) * HTB)
#define PG8_STAGE(bufoff, gbase, voff) do { _Pragma("unroll") for (int _i = 0; _i < 2; ++_i) \
        __builtin_amdgcn_global_load_lds((const unsigned*)((const char*)(gbase) + (voff)[_i]), (PG8_LAS unsigned*)(lds + (bufoff) + ldsw + _i * 8192), 16, 0, 0); } while (0)
#define PG8_LDA(dst, b, h) do { _Pragma("unroll") for (int m = 0; m < 4; ++m) _Pragma("unroll") for (int k = 0; k < 2; ++k) dst[m][k] = *(const PG8_LAS bf16x8*)(lds + PG8_SA(b, h) + aoff + m * 2048 + k * 1024); } while (0)
#define PG8_LDB(dst, b, h) do { _Pragma("unroll") for (int n = 0; n < 2; ++n) _Pragma("unroll") for (int k = 0; k < 2; ++k) dst[n][k] = *(const PG8_LAS bf16x8*)(lds + PG8_SB(b, h) + boff + n * 2048 + k * 1024); } while (0)
#define PG8_MMA(ai, bj, At, Bt) do { __builtin_amdgcn_s_setprio(1); _Pragma("unroll") for (int m = 0; m < 4; ++m) _Pragma("unroll") for (int n = 0; n < 2; ++n) _Pragma("unroll") for (int k = 0; k < 2; ++k) \
        acc[ai][bj][m][n] = __builtin_amdgcn_mfma_f32_16x16x32_bf16(Bt[n][k], At[m][k], acc[ai][bj][m][n], 0, 0, 0); __builtin_amdgcn_s_setprio(0); } while (0)
#define PG8_WAIT_V(n) asm volatile("s_waitcnt vmcnt(" #n ")" ::: "memory")
#define PG8_WAIT_L(n) asm volatile("s_waitcnt lgkmcnt(" #n ")" ::: "memory")
#define PG8_BAR __builtin_amdgcn_s_barrier()
#define PG8_SCHED __builtin_amdgcn_sched_barrier(0)
    Unit cur, nxt; int ui = 0;
    if (!S.next(0, cur)) return;
    f32x4 acc[2][2][4][2];
#pragma unroll
    for (int a = 0; a < 2; ++a)
#pragma unroll
        for (int b = 0; b < 2; ++b)
#pragma unroll
            for (int m = 0; m < 4; ++m)
#pragma unroll
                for (int n = 0; n < 2; ++n) acc[a][b][m][n] = (f32x4){0.f, 0.f, 0.f, 0.f};
    bf16x8 At[4][2], B0[2][2], B1[2][2];
    const char* cA = (const char*)g.A + (size_t)cur.pm * tstepA; const char* cB = (const char*)g.Bt + (size_t)cur.pn * tstepB;
    S.a_ready(cur);
    if constexpr (SP2) {
        PG8_STAGE(PG8_SB(0, 0), cB, voffB); PG8_STAGE(PG8_SB(0, 1), cB + hstepB, voffB); PG8_STAGE(PG8_SA(0, 0), cA, voffA); PG8_STAGE(PG8_SA(0, 1), cA + hstepA, voffA);
        if (wr == 1) PG8_BAR;
        PG8_WAIT_V(2); PG8_BAR;
        PG8_STAGE(PG8_SB(1, 0), cB + kstep, voffB); PG8_STAGE(PG8_SA(1, 0), cA + kstep, voffA); PG8_STAGE(PG8_SB(1, 1), cB + hstepB + kstep, voffB);
        PG8_WAIT_V(6); PG8_BAR;
    } else {
        PG8_STAGE(PG8_SB(0, 0), cB, voffB); PG8_STAGE(PG8_SA(0, 0), cA, voffA); PG8_STAGE(PG8_SB(0, 1), cB + hstepB, voffB); PG8_STAGE(PG8_SA(0, 1), cA + hstepA, voffA);
        if (wr == 1) PG8_BAR;
        PG8_WAIT_V(4); PG8_BAR;
        PG8_STAGE(PG8_SB(1, 0), cB + kstep, voffB); PG8_STAGE(PG8_SA(1, 0), cA + kstep, voffA); PG8_STAGE(PG8_SB(1, 1), cB + hstepB + kstep, voffB);
        PG8_WAIT_V(6); PG8_BAR;
    }
    for (;;) {
        const bool has_next = S.next(ui + 1, nxt);
        const char* nA = has_next ? (const char*)g.A + (size_t)nxt.pm * tstepA : cA; const char* nB = has_next ? (const char*)g.Bt + (size_t)nxt.pn * tstepB : cB;
        for (int t = 0; t < nt; t += 2) {
            const bool last = (t == nt - 2);
            const char* a1 = cA + (size_t)(t + 1) * kstep;
            const char* a2 = last ? nA : cA + (size_t)(t + 2) * kstep; const char* b2 = last ? nB : cB + (size_t)(t + 2) * kstep;
            const char* a3 = a2 + kstep; const char* b3 = b2 + kstep;
            if (last && has_next) S.a_ready(nxt);
            if constexpr (SP2) {
            PG8_LDB(B0, 0, 0); PG8_LDB(B1, 0, 1); PG8_SCHED; PG8_LDA(At, 0, 0); PG8_STAGE(PG8_SA(1, 1), a1 + hstepA, voffA);
            PG8_WAIT_V(8); PG8_WAIT_L(0); PG8_BAR; PG8_MMA(0, 0, At, B0); PG8_MMA(0, 1, At, B1); PG8_BAR; PG8_SCHED;
            PG8_LDA(At, 0, 1); PG8_STAGE(PG8_SB(0, 0), b2, voffB); PG8_STAGE(PG8_SB(0, 1), b2 + hstepB, voffB); PG8_STAGE(PG8_SA(0, 0), a2, voffA);
            PG8_WAIT_V(8); PG8_WAIT_L(0); PG8_BAR; PG8_MMA(1, 0, At, B0); PG8_MMA(1, 1, At, B1); PG8_BAR; PG8_SCHED;
            PG8_LDB(B0, 1, 0); PG8_LDB(B1, 1, 1); PG8_SCHED; PG8_LDA(At, 1, 0); PG8_STAGE(PG8_SA(0, 1), a2 + hstepA, voffA);
            PG8_WAIT_V(8); PG8_WAIT_L(0); PG8_BAR; PG8_MMA(0, 0, At, B0); PG8_MMA(0, 1, At, B1); PG8_BAR; PG8_SCHED;
            PG8_LDA(At, 1, 1); PG8_STAGE(PG8_SB(1, 0), b3, voffB); PG8_STAGE(PG8_SB(1, 1), b3 + hstepB, voffB); PG8_STAGE(PG8_SA(1, 0), a3, voffA);
            PG8_WAIT_V(8); PG8_WAIT_L(0); PG8_BAR; PG8_MMA(1, 0, At, B0); PG8_MMA(1, 1, At, B1); PG8_BAR; PG8_SCHED;
            } else {
            PG8_LDB(B0, 0, 0); PG8_SCHED; PG8_LDA(At, 0, 0); PG8_STAGE(PG8_SA(1, 1), a1 + hstepA, voffA);
            PG8_WAIT_L(8); PG8_BAR; PG8_WAIT_L(0); PG8_MMA(0, 0, At, B0); PG8_BAR; PG8_SCHED;
            PG8_LDB(B1, 0, 1); PG8_STAGE(PG8_SB(0, 0), b2, voffB);
            PG8_BAR; PG8_WAIT_L(0); PG8_MMA(0, 1, At, B1); PG8_BAR;
            PG8_LDA(At, 0, 1); PG8_STAGE(PG8_SA(0, 0), a2, voffA);
            PG8_BAR; PG8_WAIT_L(0); PG8_MMA(1, 0, At, B0); PG8_BAR; PG8_SCHED;
            PG8_STAGE(PG8_SB(0, 1), b2 + hstepB, voffB);
            PG8_WAIT_V(6); PG8_BAR; PG8_MMA(1, 1, At, B1); PG8_BAR;
            PG8_LDB(B0, 1, 0); PG8_SCHED; PG8_LDA(At, 1, 0); PG8_STAGE(PG8_SA(0, 1), a2 + hstepA, voffA);
            PG8_WAIT_L(8); PG8_BAR; PG8_WAIT_L(0); PG8_MMA(0, 0, At, B0); PG8_BAR; PG8_SCHED;
            PG8_LDB(B1, 1, 1); PG8_STAGE(PG8_SB(1, 0), b3, voffB);
            PG8_BAR; PG8_WAIT_L(0); PG8_MMA(0, 1, At, B1); PG8_BAR;
            PG8_LDA(At, 1, 1); PG8_STAGE(PG8_SA(1, 0), a3, voffA);
            PG8_BAR; PG8_WAIT_L(0); PG8_MMA(1, 0, At, B0); PG8_BAR; PG8_SCHED;
            PG8_STAGE(PG8_SB(1, 1), b3 + hstepB, voffB);
            PG8_WAIT_V(6); PG8_BAR; PG8_MMA(1, 1, At, B1); PG8_BAR;
            }
        }
        if constexpr (ALIGN_EPI) { if (wr == 0) PG8_BAR; }
        if constexpr (!Epi::AFTER_DRAIN) { E(acc, cur, wr, wc, fr, fq); S.done(cur); }
        if (!has_next) break;
#pragma unroll
        for (int a = 0; a < 2; ++a)
#pragma unroll
            for (int b = 0; b < 2; ++b)
#pragma unroll
                for (int m = 0; m < 4; ++m)
#pragma unroll
                    for (int n = 0; n < 2; ++n) acc[a][b][m][n] = (f32x4){0.f, 0.f, 0.f, 0.f};
        cur = nxt; cA = nA; cB = nB; ++ui;
        if constexpr (ALIGN_EPI) { if (wr == 1) PG8_BAR; }
    }
    PG8_WAIT_V(0);
    if constexpr (!ALIGN_EPI) { if (wr == 0) PG8_BAR; }
    PG8_BAR;
    if constexpr (Epi::AFTER_DRAIN) { E.fused(acc, cur, wr, wc, fr, fq, lds, wid, lane); S.done(cur); }
#undef PG8_SA
#undef PG8_SB
#undef PG8_STAGE
#undef PG8_LDA
#undef PG8_LDB
#undef PG8_MMA
#undef PG8_WAIT_V
#undef PG8_WAIT_L
#undef PG8_BAR
#undef PG8_SCHED
}
}

#define LAS __attribute__((address_space(3)))
typedef unsigned short bf16_t;
typedef short bf16x8 __attribute__((ext_vector_type(8)));
typedef short s16x4 __attribute__((ext_vector_type(4)));
typedef float f32x4 __attribute__((ext_vector_type(4)));
typedef unsigned u32x4 __attribute__((ext_vector_type(4)));
typedef unsigned u32x2 __attribute__((ext_vector_type(2)));
typedef float f32x2_t __attribute__((ext_vector_type(2))); typedef __bf16 bf16x2_t __attribute__((ext_vector_type(2)));
__device__ __forceinline__ unsigned cvt_pk_bf16(float lo, float hi) { f32x2_t v = {lo, hi}; bf16x2_t b = __builtin_convertvector(v, bf16x2_t); return __builtin_bit_cast(unsigned, b); }
#define MFMA16(a, b, c) __builtin_amdgcn_mfma_f32_16x16x32_bf16((a), (b), (c), 0, 0, 0)
__device__ __forceinline__ float bf_lo(unsigned w) { return __uint_as_float(w << 16); }
__device__ __forceinline__ float bf_hi(unsigned w) { return __uint_as_float(w & 0xffff0000u); }
__device__ __forceinline__ float bf2f(bf16_t h) { return __uint_as_float(((unsigned)h) << 16); }
__device__ __forceinline__ bf16_t f2bf(float f) { return (bf16_t)(cvt_pk_bf16(f, 0.f) & 0xffffu); }
__device__ __forceinline__ float sigmoidf_(float x) { return __builtin_amdgcn_rcpf(1.0f + __builtin_amdgcn_exp2f(-1.4426950408889634f * x)); }
__device__ __forceinline__ float rsqrt_(float x) { return __builtin_amdgcn_rsqf(x); }
__device__ __forceinline__ float xmax_16_32(float v) {
    auto r = __builtin_amdgcn_permlane16_swap(__float_as_uint(v), __float_as_uint(v), false, false);
    v = fmaxf(__uint_as_float(r[0]), __uint_as_float(r[1]));
    auto q = __builtin_amdgcn_permlane32_swap(__float_as_uint(v), __float_as_uint(v), false, false);
    return fmaxf(__uint_as_float(q[0]), __uint_as_float(q[1]));
}
__device__ __forceinline__ float xsum_16_32(float v) {
    auto r = __builtin_amdgcn_permlane16_swap(__float_as_uint(v), __float_as_uint(v), false, false);
    v = __uint_as_float(r[0]) + __uint_as_float(r[1]);
    auto q = __builtin_amdgcn_permlane32_swap(__float_as_uint(v), __float_as_uint(v), false, false);
    return __uint_as_float(q[0]) + __uint_as_float(q[1]);
}
__device__ __forceinline__ float row_prev(float v) { return __int_as_float(__builtin_amdgcn_mov_dpp(__float_as_int(v), 0x121, 0xf, 0xf, false)); }
__device__ __forceinline__ float row_next(float v) { return __int_as_float(__builtin_amdgcn_mov_dpp(__float_as_int(v), 0x12F, 0xf, 0xf, false)); }
__device__ __forceinline__ float wave_scan_sum(float v, int lane) {
    v += __int_as_float(__builtin_amdgcn_update_dpp(0, __float_as_int(v), 0x111, 0xf, 0xf, false));
    v += __int_as_float(__builtin_amdgcn_update_dpp(0, __float_as_int(v), 0x112, 0xf, 0xf, false));
    v += __int_as_float(__builtin_amdgcn_update_dpp(0, __float_as_int(v), 0x114, 0xf, 0xf, false));
    v += __int_as_float(__builtin_amdgcn_update_dpp(0, __float_as_int(v), 0x118, 0xf, 0xf, false));
    const float t0 = __int_as_float(__builtin_amdgcn_readlane(__float_as_int(v), 15)), t1 = __int_as_float(__builtin_amdgcn_readlane(__float_as_int(v), 31)), t2 = __int_as_float(__builtin_amdgcn_readlane(__float_as_int(v), 47));
    const int row = lane >> 4;
    return v + (row == 0 ? 0.f : row == 1 ? t0 : row == 2 ? (t0 + t1) : (t0 + t1 + t2));
}
__device__ __forceinline__ float wave_scan_max(float v, int lane) {
    const int ninf = __float_as_int(-3.0e38f);
    v = fmaxf(v, __int_as_float(__builtin_amdgcn_update_dpp(ninf, __float_as_int(v), 0x111, 0xf, 0xf, false)));
    v = fmaxf(v, __int_as_float(__builtin_amdgcn_update_dpp(ninf, __float_as_int(v), 0x112, 0xf, 0xf, false)));
    v = fmaxf(v, __int_as_float(__builtin_amdgcn_update_dpp(ninf, __float_as_int(v), 0x114, 0xf, 0xf, false)));
    v = fmaxf(v, __int_as_float(__builtin_amdgcn_update_dpp(ninf, __float_as_int(v), 0x118, 0xf, 0xf, false)));
    const float t0 = __int_as_float(__builtin_amdgcn_readlane(__float_as_int(v), 15)), t1 = __int_as_float(__builtin_amdgcn_readlane(__float_as_int(v), 31)), t2 = __int_as_float(__builtin_amdgcn_readlane(__float_as_int(v), 47));
    const int row = lane >> 4;
    return fmaxf(v, row == 0 ? -3.0e38f : row == 1 ? t0 : row == 2 ? fmaxf(t0, t1) : fmaxf(fmaxf(t0, t1), t2));
}
__device__ __forceinline__ float wave_sum(float v) {
#pragma unroll
    for (int o = 1; o < 64; o <<= 1) v += __shfl_xor(v, o);
    return v;
}

constexpr size_t MiB = 1u << 20;
constexpr size_t WS_CTL = 0;
constexpr size_t WS_BT1 = 1 * MiB, WS_WG = 6 * MiB, WS_WUQ = 10 * MiB, WS_WUKV = 10 * MiB + 512 * 1024, WS_WOA = 11 * MiB, WS_WOM = 12 * MiB,
                 WS_WOUT = 13 * MiB, WS_WFF = 15 * MiB, WS_WDN = 26 * MiB;
constexpr size_t WS_COS = 41 * MiB, WS_SIN = 43 * MiB, WS_RSQ = 45 * MiB, WS_RSKV = 45 * MiB + 512 * 1024, WS_RS2 = 46 * MiB, WS_GI = 47 * MiB,
                 WS_LF = 50 * MiB, WS_KR = 53 * MiB;
constexpr size_t WS_SSQQ = 46 * MiB + 512 * 1024;
constexpr size_t WS_R1 = 61 * MiB;
constexpr size_t WS_Q = 465 * MiB, WS_KV = 587 * MiB;
constexpr size_t WS_AO = 749 * MiB, WS_HF = 830 * MiB, WS_HB = 911 * MiB, WS_END = 992 * MiB;
static_assert(WS_R1 + (size_t)MP * ZW * 2 <= WS_Q && WS_Q + (size_t)MP * 768 * 2 <= WS_KV && WS_KV + (size_t)MP * 2048 <= WS_AO, "ws map");
static_assert(WS_AO + (size_t)MP * 1024 <= WS_HF && WS_HF + (size_t)MP * 1024 <= WS_HB && WS_HB + (size_t)MP * 1024 <= WS_END, "ws map 2");
static_assert(WS_R1 + (size_t)MP * DFF * 2 <= WS_KV && WS_AO + (size_t)MP * 2048 <= WS_HB, "ws map 3");

struct Params { const float* in[22]; float* out; unsigned char* ws; int ph_lo, ph_hi; };
enum { I_XP = 0, I_XS, I_META, I_NMIX, I_WIN, I_QN, I_WUQ, I_KVN, I_WUKV, I_BI, I_BF, I_MN, I_WOA, I_WOM, I_WOUT, I_NFFN, I_WUP, I_WGATE, I_CW, I_CB, I_WDN, I_NFIN };

__device__ __forceinline__ void row_info(int m, int& seq, int& l) { if (m < M_P) { seq = m / L_P; l = m - seq * L_P; } else { seq = 32; l = m - M_P; } }
__device__ __forceinline__ const float* hrow_ptr3(const float* xp, const float* xs, const float* meta, int m) {
    int seq, l; row_info(m, seq, l);
    if (l < NMETA) return meta + (size_t)l * DM;
    if (seq < 32) return xp + ((size_t)seq * S_P + (l - NMETA)) * DM;
    return xs + (size_t)(l - NMETA) * DM;
}
__device__ __forceinline__ const float* hrow_ptr(const Params& P, int m) { return hrow_ptr3(P.in[I_XP], P.in[I_XS], P.in[I_META], m); }

__device__ __forceinline__ void wt_item(const float* W, int ldw, int col0, int nvalid, int kvalid, int k0, const float* rs, float cs, bf16_t* dst, int K, LAS float* scr, int lane) {
#pragma unroll 8
    for (int i = 0; i < 32; ++i) {
        const int kk = 2 * i + (lane >> 5), n = lane & 31;
        float v = 0.f;
        if (n < nvalid && k0 + kk < kvalid) { v = W[(size_t)(k0 + kk) * ldw + col0 + n] * cs; if (rs) v *= rs[k0 + kk]; }
        scr[kk * 33 + n] = v;
    }
    asm volatile("s_waitcnt lgkmcnt(0)" ::: "memory");
    const int c = lane & 7;
#pragma unroll
    for (int j = 0; j < 4; ++j) {
        const int n = (lane >> 3) + 8 * j; const LAS float* s = scr + (8 * c) * 33 + n;
        u32x4 o; o.x = cvt_pk_bf16(s[0 * 33], s[1 * 33]); o.y = cvt_pk_bf16(s[2 * 33], s[3 * 33]); o.z = cvt_pk_bf16(s[4 * 33], s[5 * 33]); o.w = cvt_pk_bf16(s[6 * 33], s[7 * 33]);
        *(u32x4*)(dst + (size_t)n * K + k0 + 8 * c) = o;
    }
    asm volatile("s_waitcnt lgkmcnt(0)" ::: "memory");
}
struct WJob { int dst_off_mib_x2; int row0; int nrows; int K; int src; int ldw; int col0; int nvalid; int rs; int special; };
__device__ __forceinline__ void phase_prologue(const Params& P, LAS unsigned char* lds) {
    const int tid = threadIdx.x, lane = tid & 63, wid = tid >> 6;
    const int gw = blockIdx.x * 8 + wid, NGW = gridDim.x * 8;
    LAS float* scr = (LAS float*)(lds + wid * 16384);
    unsigned char* ws = P.ws;
    for (int i = blockIdx.x * 512 + tid; i < 16384; i += gridDim.x * 512) ((unsigned*)(ws + WS_CTL))[i] = 0u;
    for (int i = blockIdx.x * 512 + tid; i < MP; i += gridDim.x * 512) { ((float*)(ws + WS_RS2))[i] = 0.f; ((float*)(ws + WS_RSQ))[i] = 0.f; ((float*)(ws + WS_RSKV))[i] = 0.f; ((float*)(ws + WS_SSQQ))[i] = 0.f; }
    constexpr int NJ = 14;
    static constexpr WJob jobs[NJ] = {
        {2, 0, 416, 1024, I_WIN, 4528, 0, 416, -1, 0},
        {2, 416, 32, 1024, I_WIN, 4528, 2464, 16, -1, 0},
        {2, 448, 64, 1024, I_WIN, 4528, 0, 0, -1, 0},
        {2, 512, 512, 1024, I_WIN, 4528, 416, 512, -1, 0},
        {2, 1024, 512, 1024, I_WIN, 4528, 928, 512, -1, 1},
        {2, 1536, 1024, 1024, I_WIN, 4528, 1440, 1024, -1, 0},
        {12, 0, 2048, 1024, I_WIN, 4528, 2480, 2048, -1, 0},
        {20, 0, 768, 256, I_WUQ, 768, 0, 768, I_QN, 4},
        {21, 0, 1024, 256, I_WUKV, 1024, 0, 1024, I_KVN, 3},
        {22, 0, 1024, 512, I_WOA, 1024, 0, 1024, -1, 0},
        {24, 0, 1024, 512, I_WOM, 1024, 0, 1024, -1, 0},
        {26, 0, 1024, 1024, I_WOUT, 1024, 0, 1024, -1, 0},
        {30, 0, 5632, 1024, I_WUP, 2816, 0, 5632, I_NFFN, 2},
        {52, 0, 1024, 2816, I_WDN, 1024, 0, 1024, -1, 0},
    };
    int total = 0;
#pragma unroll
    for (int j = 0; j < NJ; ++j) total += (jobs[j].nrows / 32) * (jobs[j].K / 64);
    for (int it = gw; it < total; it += NGW) {
        int r = it;
#pragma unroll
        for (int j = 0; j < NJ; ++j) {
            const int cnt = (jobs[j].nrows / 32) * (jobs[j].K / 64);
            if (r >= 0 && r < cnt) {
                const int nkb = jobs[j].K / 64, nb = r / nkb, kb = r % nkb;
                const float* src = P.in[jobs[j].src]; int col0 = jobs[j].col0 + 32 * nb; int nvalid = jobs[j].nvalid - 32 * nb; float cs = 1.f;
                int drow = jobs[j].row0 + 32 * nb;
                if (jobs[j].special == 1) cs = 0.08838834764831845f;
                if (jobs[j].special == 4) cs = QSCALE;
                if (jobs[j].special == 2) { const int pp = nb >> 3, within = nb & 7, half = within >> 2, cb = within & 3; src = half ? P.in[I_WGATE] : P.in[I_WUP]; col0 = 128 * pp + 32 * cb; nvalid = 32; }
                nvalid = nvalid < 0 ? 0 : (nvalid > 32 ? 32 : nvalid);
                bf16_t* dst = (bf16_t*)(ws + (size_t)jobs[j].dst_off_mib_x2 * (MiB / 2)) + (size_t)drow * jobs[j].K;
                wt_item(src, jobs[j].ldw, col0, nvalid, jobs[j].special == 3 ? 128 : jobs[j].K, 64 * kb, jobs[j].rs >= 0 ? P.in[jobs[j].rs] : nullptr, cs, dst, jobs[j].K, scr, lane);
            }
            r -= cnt;
        }
    }
    bf16_t* U = (bf16_t*)P.out;
    const float* gm = P.in[I_NMIX];
    for (int m0 = gw; m0 < MP; m0 += 2 * NGW) {
        f32x4 v[2][4]; float ss[2] = {0.f, 0.f}; bool ok[2];
#pragma unroll
        for (int h = 0; h < 2; ++h) {
            const int m = m0 + h * NGW; ok[h] = m < M_TOK;
            const f32x4* xr = (const f32x4*)hrow_ptr(P, ok[h] ? m : 0) + lane;
#pragma unroll
            for (int j = 0; j < 4; ++j) { v[h][j] = xr[64 * j]; ss[h] += (v[h][j].x * v[h][j].x + v[h][j].y * v[h][j].y) + (v[h][j].z * v[h][j].z + v[h][j].w * v[h][j].w); }
        }
#pragma unroll
        for (int h = 0; h < 2; ++h) {
            const int m = m0 + h * NGW; if (m >= MP) continue;
            unsigned long long* o8 = (unsigned long long*)(U + (size_t)m * DM) + lane;
            const float rstd = ok[h] ? rsqrt_(wave_sum(ss[h]) * (1.f / DM) + EPS) : 0.f;
#pragma unroll
            for (int j = 0; j < 4; ++j) {
                const f32x4 gg = ((const f32x4*)gm)[lane + 64 * j];
                o8[64 * j] = (unsigned long long)cvt_pk_bf16(v[h][j].x * rstd * gg.x, v[h][j].y * rstd * gg.y) | ((unsigned long long)cvt_pk_bf16(v[h][j].z * rstd * gg.z, v[h][j].w * rstd * gg.w) << 32);
            }
        }
    }
#ifdef MK_FILL
    {
        u32x4* fp = (u32x4*)(ws + 45 * MiB); const size_t nf = (size_t)(992 - 45) * MiB / 16;
        const u32x4 fv = {MK_FILL, MK_FILL, MK_FILL, MK_FILL};
        for (size_t i = (size_t)blockIdx.x * 512 + tid; i < nf; i += (size_t)gridDim.x * 512) fp[i] = fv;
    }
#endif
    float* cosT = (float*)(ws + WS_COS); float* sinT = (float*)(ws + WS_SIN);
    for (int i = blockIdx.x * 512 + tid; i < L_S * 16; i += gridDim.x * 512) {
        const int l = i >> 4, j = i & 15;
        const float q4 = (j & 3) == 0 ? 1.0f : (j & 3) == 1 ? 0.5623413251903491f : (j & 3) == 2 ? 0.31622776601683794f : 0.1778279410038923f;
        const float d4 = (j >> 2) == 0 ? 1.0f : (j >> 2) == 1 ? 0.1f : (j >> 2) == 2 ? 0.01f : 0.001f;
        const float inv = (float)((double)q4 * (double)d4);
        const float ang = (float)l * inv;
        const double x = (double)ang, k = rint(x * 0.15915494309189535);
        const float r = (float)fma(-k, 6.283185307179586, x);
        cosT[i] = cosf(r); sinT[i] = sinf(r);
    }
}

__device__ __forceinline__ void phase_rowsmall(const Params& P) {
    const int tid = threadIdx.x, lane = tid & 63, wid = tid >> 6;
    const int gw = blockIdx.x * 8 + wid, NGW = gridDim.x * 8;
    unsigned char* ws = P.ws;
    const bf16_t* Z1 = (const bf16_t*)(ws + WS_R1); bf16_t* Z1w = (bf16_t*)(ws + WS_R1);
    float* GI = (float*)(ws + WS_GI); float* LF = (float*)(ws + WS_LF); bf16_t* KR = (bf16_t*)(ws + WS_KR);
    const float* cosT = (const float*)(ws + WS_COS); const float* sinT = (const float*)(ws + WS_SIN);
    for (int m0 = gw; m0 < MP; m0 += 2 * NGW) {
        u32x2 av[2]; unsigned bv[2]; float s1v[2], s2v[2];
#pragma unroll
        for (int h = 0; h < 2; ++h) {
            const int m = (m0 + h * NGW) < MP ? (m0 + h * NGW) : m0;
            const bf16_t* z = Z1 + (size_t)m * ZW;
            av[h] = *(const u32x2*)(z + 4 * lane);
            bv[h] = *(const unsigned*)(z + 256 + 2 * lane);
        }
#pragma unroll
        for (int h = 0; h < 2; ++h) {
            const u32x2 a = av[h]; const unsigned b = bv[h];
            s1v[h] = bf_lo(a.x) * bf_lo(a.x) + bf_hi(a.x) * bf_hi(a.x) + bf_lo(a.y) * bf_lo(a.y) + bf_hi(a.y) * bf_hi(a.y);
            s2v[h] = bf_lo(b) * bf_lo(b) + bf_hi(b) * bf_hi(b);
        }
#pragma unroll
        for (int o = 1; o < 64; o <<= 1) { s1v[0] += __shfl_xor(s1v[0], o); s1v[1] += __shfl_xor(s1v[1], o); s2v[0] += __shfl_xor(s2v[0], o); s2v[1] += __shfl_xor(s2v[1], o); }
#pragma unroll
        for (int h = 0; h < 2; ++h) {
            const int m = m0 + h * NGW; if (m >= MP) continue;
            const bf16_t* z = Z1 + (size_t)m * ZW;
            const u32x2 a = av[h]; const unsigned b = bv[h];
            {
                const float r1 = rsqrt_(s1v[h] * (1.f / 256.f) + EPS), r2 = rsqrt_(s2v[h] * (1.f / 128.f) + EPS);
                u32x2 na; na.x = cvt_pk_bf16(bf_lo(a.x) * r1, bf_hi(a.x) * r1); na.y = cvt_pk_bf16(bf_lo(a.y) * r1, bf_hi(a.y) * r1);
                *(u32x2*)(Z1w + (size_t)m * ZW + 4 * lane) = na;
                *(unsigned*)(Z1w + (size_t)m * ZW + 256 + 2 * lane) = cvt_pk_bf16(bf_lo(b) * r2, bf_hi(b) * r2);
            }
            int seq, l; row_info(m < M_TOK ? m : M_TOK - 1, seq, l);
            if (lane < 16) {
                const float x1 = bf2f(z[384 + lane]), x2 = bf2f(z[400 + lane]);
                const float c = cosT[l * 16 + lane], sn = sinT[l * 16 + lane];
                KR[(size_t)m * 32 + lane] = f2bf(x1 * c - x2 * sn);
                KR[(size_t)m * 32 + 16 + lane] = f2bf(x1 * sn + x2 * c);
            } else if (lane < 24) {
                const int i = lane - 16;
                GI[(size_t)m * 8 + i] = bf2f(z[416 + i]) + P.in[I_BI][i];
            } else if (lane < 32) {
                const int i = lane - 24;
                const float x = bf2f(z[424 + i]) + P.in[I_BF][i];
                LF[(size_t)m * 8 + i] = fminf(x, 0.f) - log1pf(expf(-fabsf(x)));
            }
        }
    }
}

enum { EM_PLAIN = 0, EM_KV, EM_Q, EM_SIG, EM_MRGA, EM_MRGB, EM_RES1, EM_DOWN, EM_Z1 };
template <int MODE> struct EpiG {
    static constexpr bool PERM = true, AFTER_DRAIN = false;
    bf16_t* O; int ldc; const float* rs; const bf16_t* G; const float* cosT; const float* sinT; const float* xp; const float* xs; const float* meta; float* out; const float* aux0; const float* aux1;
    __device__ __forceinline__ void operator()(const pg8::f32x4 (&acc)[2][2][4][2], const pg8::Unit& u, int wr, int wc, int fr, int fq) const {
#pragma unroll
        for (int ai = 0; ai < 2; ++ai)
#pragma unroll
            for (int m = 0; m < 4; ++m) {
                const int row = u.pm * 256 + ai * 128 + wr * 64 + m * 16 + fr;
                float rsv = 1.f; if (MODE == EM_KV || MODE == EM_Q) rsv = rsqrt_(rs[row] * (MODE == EM_Q ? (1.f / 256.f) : (1.f / 128.f)) + EPS);
                int seq = 0, l = 0; const float* hp = nullptr; bool live = true; float ssq = 0.f;
                if (MODE == EM_RES1 || MODE == EM_Z1) { row_info(row < M_TOK ? row : M_TOK - 1, seq, l); }
                int hrow = row;
                if (MODE == EM_DOWN) { seq = row < NB_P * S_P ? (row >> 11) : 32; l = row - seq * S_P + NMETA; hrow = (seq < 32 ? seq * L_P : M_P) + l; }
                if (MODE == EM_RES1) { live = row < M_TOK; hp = hrow_ptr3(xp, xs, meta, row < M_TOK ? row : 0); }

#pragma unroll
                for (int bj = 0; bj < 2; ++bj) {
                    const int cbase = u.pn * 256 + bj * 128 + wc * 32;
                    const int col = cbase + 8 * fq;
                    f32x4 v0 = acc[ai][bj][m][0], v1 = acc[ai][bj][m][1];
                    if (MODE == EM_Z1) {
                        if (u.pn == 0 || (u.pn == 1 && bj == 0))
                            ssq += (v0[0] * v0[0] + v0[1] * v0[1]) + (v0[2] * v0[2] + v0[3] * v0[3]) + (v1[0] * v1[0] + v1[1] * v1[1]) + (v1[2] * v1[2] + v1[3] * v1[3]);
                        if (u.pn == 1 && bj == 1 && wc == 0) {
                            const int lz = l < L_S ? l : L_S - 1, j0 = 8 * (fq & 1);
                            const f32x4 c0 = *(const f32x4*)(cosT + lz * 16 + j0), c1 = *(const f32x4*)(cosT + lz * 16 + j0 + 4);
                            const f32x4 s0 = *(const f32x4*)(sinT + lz * 16 + j0), s1 = *(const f32x4*)(sinT + lz * 16 + j0 + 4);
                            f32x4 y0, y1;
#pragma unroll
                            for (int i = 0; i < 4; ++i) { y0[i] = __shfl_xor(v0[i], 32); y1[i] = __shfl_xor(v1[i], 32); }
                            const float sg = (fq < 2) ? -1.f : 1.f;
                            const f32x4 r0 = v0 * c0 + (y0 * s0) * sg, r1 = v1 * c1 + (y1 * s1) * sg;
                            u32x4 w; w.x = cvt_pk_bf16(r0[0], r0[1]); w.y = cvt_pk_bf16(r0[2], r0[3]); w.z = cvt_pk_bf16(r1[0], r1[1]); w.w = cvt_pk_bf16(r1[2], r1[3]);
                            *(u32x4*)(const_cast<bf16_t*>(G) + (size_t)row * 32 + 8 * fq) = w;
                        }
                        if (u.pn == 1 && bj == 1 && wc == 1 && fq < 2) {
                            const float* bb = fq == 0 ? aux0 : aux1;
                            float gv[8] = {v0[0] + bb[0], v0[1] + bb[1], v0[2] + bb[2], v0[3] + bb[3], v1[0] + bb[4], v1[1] + bb[5], v1[2] + bb[6], v1[3] + bb[7]};
                            if (fq == 1) {
#pragma unroll
                                for (int i = 0; i < 8; ++i) gv[i] = fminf(gv[i], 0.f) - log1pf(expf(-fabsf(gv[i])));
                            }
                            float* gp = const_cast<float*>(fq == 0 ? xs : meta) + (size_t)row * 8;
                            *(f32x4*)gp = (f32x4){gv[0], gv[1], gv[2], gv[3]}; *(f32x4*)(gp + 4) = (f32x4){gv[4], gv[5], gv[6], gv[7]};
                        }
                    }
                    if (MODE == EM_KV || MODE == EM_Q) { v0 = v0 * rsv; v1 = v1 * rsv; }
                    if (MODE == EM_SIG) {
#pragma unroll
                        for (int i = 0; i < 4; ++i) { v0[i] = sigmoidf_(v0[i]); v1[i] = sigmoidf_(v1[i]); }
                    }
                    if (MODE == EM_MRGA || MODE == EM_MRGB) {
                        const u32x4 gt = *(const u32x4*)(G + (size_t)row * ZW + (MODE == EM_MRGB ? 1024 : 0) + col);
                        v0[0] *= bf_lo(gt.x); v0[1] *= bf_hi(gt.x); v0[2] *= bf_lo(gt.y); v0[3] *= bf_hi(gt.y);
                        v1[0] *= bf_lo(gt.z); v1[1] *= bf_hi(gt.z); v1[2] *= bf_lo(gt.w); v1[3] *= bf_hi(gt.w);
                        if (MODE == EM_MRGB) {
                            const u32x4 y = *(const u32x4*)(O + (size_t)row * ldc + col);
                            v0[0] += bf_lo(y.x); v0[1] += bf_hi(y.x); v0[2] += bf_lo(y.y); v0[3] += bf_hi(y.y);
                            v1[0] += bf_lo(y.z); v1[1] += bf_hi(y.z); v1[2] += bf_lo(y.w); v1[3] += bf_hi(y.w);
                        }
                    }
                    if (MODE == EM_RES1) {
                        if (live) { const f32x4 h0 = *(const f32x4*)(hp + col), h1 = *(const f32x4*)(hp + col + 4); v0 = v0 + h0; v1 = v1 + h1; }
                        ssq += (v0[0] * v0[0] + v0[1] * v0[1]) + (v0[2] * v0[2] + v0[3] * v0[3]) + (v1[0] * v1[0] + v1[1] * v1[1]) + (v1[2] * v1[2] + v1[3] * v1[3]);
                    }
                    if (MODE == EM_DOWN) {
                        if (live) {
                            const u32x4 hb = *(const u32x4*)(G + (size_t)hrow * 1024 + col);
                            v0[0] += bf_lo(hb.x); v0[1] += bf_hi(hb.x); v0[2] += bf_lo(hb.y); v0[3] += bf_hi(hb.y);
                            v1[0] += bf_lo(hb.z); v1[1] += bf_hi(hb.z); v1[2] += bf_lo(hb.w); v1[3] += bf_hi(hb.w);
                            const_cast<pg8::f32x4&>(acc[ai][bj][m][0]) = v0; const_cast<pg8::f32x4&>(acc[ai][bj][m][1]) = v1;
                            ssq += (v0[0] * v0[0] + v0[1] * v0[1]) + (v0[2] * v0[2] + v0[3] * v0[3]) + (v1[0] * v1[0] + v1[1] * v1[1]) + (v1[2] * v1[2] + v1[3] * v1[3]);
                        }
                    } else {
                        if (live) {
                            u32x4 w; w.x = cvt_pk_bf16(v0[0], v0[1]); w.y = cvt_pk_bf16(v0[2], v0[3]); w.z = cvt_pk_bf16(v1[0], v1[1]); w.w = cvt_pk_bf16(v1[2], v1[3]);
                            *(u32x4*)(O + (size_t)row * ldc + col) = w;
                        }
                    }
                }
                if (MODE == EM_Z1) {
                    if (u.pn <= 1) { ssq = xsum_16_32(ssq); if (fq == 0) atomicAdd(const_cast<float*>(u.pn == 0 ? rs : xp) + row, ssq); }
                }
                if (MODE == EM_RES1 || MODE == EM_DOWN) {
                    ssq = xsum_16_32(ssq);
                    if (live && fq == 0) atomicAdd(const_cast<float*>(rs) + row, ssq);
                }
                if (MODE != EM_PLAIN && MODE != EM_SIG) asm volatile("" ::: "memory");
            }
        if (MODE == EM_DOWN) {
            unsigned* cnt = (unsigned*)const_cast<float*>(sinT) + u.pm;
            asm volatile("s_waitcnt vmcnt(0)" ::: "memory");
            __syncthreads();
            if (threadIdx.x == 0) {
                __builtin_amdgcn_fence(__ATOMIC_RELEASE, "agent");
                __hip_atomic_fetch_add(cnt, 1u, __ATOMIC_RELAXED, __HIP_MEMORY_SCOPE_AGENT);
                unsigned spins = 0;
                while (__hip_atomic_load(cnt, __ATOMIC_RELAXED, __HIP_MEMORY_SCOPE_AGENT) < 4u && ++spins < (1u << 17)) __builtin_amdgcn_s_sleep(1);
                __builtin_amdgcn_fence(__ATOMIC_ACQUIRE, "agent");
                asm volatile("s_waitcnt vmcnt(0)" ::: "memory");
            }
            __syncthreads();
#pragma unroll
            for (int ai = 0; ai < 2; ++ai)
#pragma unroll
                for (int m = 0; m < 4; ++m) {
                    const int row = u.pm * 256 + ai * 128 + wr * 64 + m * 16 + fr;
                    const float ss = __hip_atomic_load(const_cast<float*>(rs) + row, __ATOMIC_RELAXED, __HIP_MEMORY_SCOPE_AGENT);
                    const float rstd = rsqrt_(ss * (1.f / DM) + EPS);
#pragma unroll
                    for (int bj = 0; bj < 2; ++bj) {
                        const int col = u.pn * 256 + bj * 128 + wc * 32 + 8 * fq;
                        const f32x4 g0 = *(const f32x4*)(cosT + col), g1 = *(const f32x4*)(cosT + col + 4);
                        float* op = out + (size_t)row * DM + col;
                        *(f32x4*)op = acc[ai][bj][m][0] * rstd * g0; *(f32x4*)(op + 4) = acc[ai][bj][m][1] * rstd * g1;
                    }
                    asm volatile("" ::: "memory");
                }
        }
    }
};

struct EpiFfn {
    static constexpr bool PERM = true, AFTER_DRAIN = false;
    bf16_t* T; const float* rs2; const float* cw; const float* cb;
    __device__ __forceinline__ void operator()(const pg8::f32x4 (&acc)[2][2][4][2], const pg8::Unit& u, int wr, int wc, int fr, int fq) const {
        const int f0 = u.pn * 128 + wc * 32 + 8 * fq;
#pragma unroll
        for (int ai = 0; ai < 2; ++ai) {
            const int rbase = u.pm * 248 + 62 * (2 * ai + wr) - 1;
            float rsv[4]; int lpos[4], llen[4], orow[4];
#pragma unroll
            for (int m = 0; m < 4; ++m) {
                int gr = rbase + 16 * m + fr; gr = gr < 0 ? 0 : (gr >= M_TOK ? M_TOK - 1 : gr);
                rsv[m] = rsqrt_(rs2[gr] * (1.f / DM) + EPS); int seq; row_info(gr, seq, lpos[m]); llen[m] = seq < 32 ? L_P : L_S;
                orow[m] = (rbase + 16 * m + fr < M_TOK && lpos[m] >= NMETA) ? (seq < 32 ? seq * S_P : NB_P * S_P) + lpos[m] - NMETA : -1;
            }
#pragma unroll
            for (int n = 0; n < 2; ++n) {
                const f32x4 w0 = *(const f32x4*)(cw + f0 + 4 * n), w1 = *(const f32x4*)(cw + DFF + f0 + 4 * n), w2 = *(const f32x4*)(cw + 2 * DFF + f0 + 4 * n);
                const f32x4 bb = *(const f32x4*)(cb + f0 + 4 * n);
                const f32x4 zero4 = {0.f, 0.f, 0.f, 0.f};
                f32x4 upm = acc[ai][0][0][n] * rsv[0], tp_prev = zero4, tn_cur;
#pragma unroll
                for (int i = 0; i < 4; ++i) tn_cur[i] = row_next(upm[i]);
#pragma unroll
                for (int m = 0; m < 4; ++m) {
                    f32x4 tp_cur, up_next = zero4, tn_next = zero4;
#pragma unroll
                    for (int i = 0; i < 4; ++i) tp_cur[i] = row_prev(upm[i]);
                    if (m < 3) {
                        up_next = acc[ai][0][m < 3 ? m + 1 : 3][n] * rsv[m < 3 ? m + 1 : 3];
#pragma unroll
                        for (int i = 0; i < 4; ++i) tn_next[i] = row_next(up_next[i]);
                    }
                    f32x4 pv = (fr == 0) ? tp_prev : tp_cur;
                    f32x4 nv = (fr == 15) ? tn_next : tn_cur;
                    if (lpos[m] == 0) pv = zero4;
                    if (lpos[m] == llen[m] - 1) nv = zero4;
                    const f32x4 a = w0 * pv + w1 * upm + w2 * nv + bb;
                    const f32x4 gt = acc[ai][1][m][n] * rsv[m];
                    f32x4 t;
#pragma unroll
                    for (int i = 0; i < 4; ++i) {
                        const float x = a[i], z = 1.5957691216057308f * (x + 0.044715f * x * x * x);
                        t[i] = x * sigmoidf_(z) * gt[i];
                    }
                    const int rr = 16 * m + fr;
                    u32x2 ow; ow.x = cvt_pk_bf16(t[0], t[1]); ow.y = cvt_pk_bf16(t[2], t[3]);
                    if (rr >= 1 && rr <= 62 && orow[m] >= 0) *(u32x2*)(T + (size_t)orow[m] * DFF + f0 + 4 * n) = ow;
                    tp_prev = tp_cur; upm = up_next; tn_cur = tn_next;
                }
                asm volatile("" ::: "memory");
            }
        }
    }
};

constexpr int AT_KP = 104, AT_VP = 72, AT_KBUF = 64 * AT_KP * 2, AT_VBUF = 64 * AT_VP * 2, AT_VOFF = 2 * AT_KBUF;
template <int NQS> __device__ __forceinline__ void attn_unit(const Params& P, LAS unsigned char* L, int seq, int head, int qrow0, int nocomp = 0) {
    int tid_ = threadIdx.x; asm volatile("" : "+v"(tid_));
    const int tid = tid_, lane = tid & 63, wid = __builtin_amdgcn_readfirstlane(tid >> 6), g = lane >> 4, c16 = lane & 15;
    const int Lseq = seq < 32 ? L_P : L_S, sb = seq < 32 ? seq * L_P : M_P;
    const int NT = (Lseq + 63) >> 6;
    unsigned char* ws = P.ws;
    const bf16_t* Qg = (const bf16_t*)(ws + WS_Q); const bf16_t* KVg = (const bf16_t*)(ws + WS_KV); const bf16_t* KRg = (const bf16_t*)(ws + WS_KR);
    bf16_t* AO = (bf16_t*)(ws + WS_AO);
    const int skey = tid >> 3, sc = tid & 7;
    const int vpos = (skey & 32) | (((skey >> 2) & 3) << 3) | (((skey >> 4) & 1) << 2) | (skey & 3);
    const int vcol = ((((vpos >> 3) ^ sc) & 7) << 3) | (vpos & 7);
    const bf16_t* gk = KVg + (size_t)(sb + skey) * 1024 + head * 128 + 8 * sc;
    const bf16_t* gr = KRg + (size_t)(sb + skey) * 32 + 4 * sc;
    u32x4 rk, rv; u32x2 rr;
#define AT_LOAD(t) do { rk = *(const u32x4*)(gk + (size_t)(t) * 64 * 1024); rv = *(const u32x4*)(gk + 64 + (size_t)(t) * 64 * 1024); rr = *(const u32x2*)(gr + (size_t)(t) * 64 * 32); } while (0)
#define AT_STORE(buf) do { LAS unsigned char* kb_ = L + (buf) * AT_KBUF; LAS unsigned char* vb_ = L + 4 * AT_KBUF + (buf) * AT_VBUF; \
        *(LAS u32x4*)(kb_ + (skey * AT_KP + 8 * sc) * 2) = rk; *(LAS u32x2*)(kb_ + (skey * AT_KP + 64 + 4 * sc) * 2) = rr; \
        LAS bf16_t* vt_ = (LAS bf16_t*)vb_ + (8 * sc) * AT_VP + vcol; \
        vt_[0 * AT_VP] = (bf16_t)(rv.x & 0xffffu); vt_[1 * AT_VP] = (bf16_t)(rv.x >> 16); vt_[2 * AT_VP] = (bf16_t)(rv.y & 0xffffu); vt_[3 * AT_VP] = (bf16_t)(rv.y >> 16); \
        vt_[4 * AT_VP] = (bf16_t)(rv.z & 0xffffu); vt_[5 * AT_VP] = (bf16_t)(rv.z >> 16); vt_[6 * AT_VP] = (bf16_t)(rv.w & 0xffffu); vt_[7 * AT_VP] = (bf16_t)(rv.w >> 16); } while (0)
    const int q0 = qrow0 + wid * 16 * NQS;
    const bool active = (q0 < Lseq) && !nocomp;
    bf16x8 qf[NQS][3];
#pragma unroll
    for (int qs = 0; qs < NQS; ++qs) {
        int qr = q0 + 16 * qs + c16; qr = qr < Lseq ? qr : Lseq - 1;
#pragma unroll
        for (int ks = 0; ks < 3; ++ks) qf[qs][ks] = *(const bf16x8*)(Qg + (size_t)(sb + qr) * 768 + head * 96 + 32 * ks + 8 * g);
        {
            const u32x4 own = __builtin_bit_cast(u32x4, qf[qs][2]);
            u32x4 oth; oth.x = __shfl_xor(own.x, 32); oth.y = __shfl_xor(own.y, 32); oth.z = __shfl_xor(own.z, 32); oth.w = __shfl_xor(own.w, 32);
            const float* ct = (const float*)(ws + WS_COS) + qr * 16 + 8 * (g & 1); const float* sn = (const float*)(ws + WS_SIN) + qr * 16 + 8 * (g & 1);
            const f32x4 c0 = *(const f32x4*)ct, c1 = *(const f32x4*)(ct + 4), s0 = *(const f32x4*)sn, s1 = *(const f32x4*)(sn + 4);
            const float sg = (g < 2) ? -1.f : 1.f;
            u32x4 r;
            r.x = cvt_pk_bf16(bf_lo(own.x) * c0[0] + sg * bf_lo(oth.x) * s0[0], bf_hi(own.x) * c0[1] + sg * bf_hi(oth.x) * s0[1]);
            r.y = cvt_pk_bf16(bf_lo(own.y) * c0[2] + sg * bf_lo(oth.y) * s0[2], bf_hi(own.y) * c0[3] + sg * bf_hi(oth.y) * s0[3]);
            r.z = cvt_pk_bf16(bf_lo(own.z) * c1[0] + sg * bf_lo(oth.z) * s1[0], bf_hi(own.z) * c1[1] + sg * bf_hi(oth.z) * s1[1]);
            r.w = cvt_pk_bf16(bf_lo(own.w) * c1[2] + sg * bf_lo(oth.w) * s1[2], bf_hi(own.w) * c1[3] + sg * bf_hi(oth.w) * s1[3]);
            qf[qs][2] = __builtin_bit_cast(bf16x8, r);
        }
    }
    f32x4 o[4][NQS]; float mrun[NQS], lsum[NQS];
#pragma unroll
    for (int qs = 0; qs < NQS; ++qs) { mrun[qs] = 0.f; lsum[qs] = 0.f;
#pragma unroll
        for (int dt = 0; dt < 4; ++dt) o[dt][qs] = (f32x4){0.f, 0.f, 0.f, 0.f}; }
    AT_LOAD(0); AT_STORE(0); AT_LOAD(1); AT_STORE(1);
    __syncthreads();
    for (int t = 0; t < NT; ++t) {
        const int buf = t & 3;
        const LAS unsigned char* kb = L + buf * AT_KBUF; const LAS unsigned char* vb = L + 4 * AT_KBUF + buf * AT_VBUF;
        f32x4 st[4][NQS];
        if (t + 2 < NT) AT_LOAD(t + 2);
        if (active) {
#pragma unroll
            for (int kt = 0; kt < 4; ++kt) {
#pragma unroll
                for (int qs = 0; qs < NQS; ++qs) { const float nm = -mrun[qs]; st[kt][qs] = (f32x4){nm, nm, nm, nm}; }
#pragma unroll
                for (int ks = 0; ks < 3; ++ks) {
                    const bf16x8 kf = *(const LAS bf16x8*)(kb + ((16 * kt + c16) * AT_KP + 32 * ks + 8 * g) * 2);
#pragma unroll
                    for (int qs = 0; qs < NQS; ++qs) st[kt][qs] = MFMA16(kf, qf[qs][ks], st[kt][qs]);
                }
                if (kt == 1) __builtin_amdgcn_sched_barrier(0);
            }
        }
        if (active) {
            if (t == NT - 1) {
#pragma unroll
                for (int kt = 0; kt < 4; ++kt)
#pragma unroll
                    for (int r = 0; r < 4; ++r) if (64 * t + 16 * kt + 4 * g + r >= Lseq) {
#pragma unroll
                        for (int qs = 0; qs < NQS; ++qs) st[kt][qs][r] = -INFINITY; }
            }
            bf16x8 pb[NQS][2]; float psv[NQS];
            if (t == 0) {
#pragma unroll
                for (int qs = 0; qs < NQS; ++qs) {
                    float mx = fmaxf(fmaxf(st[0][qs][0], st[0][qs][1]), fmaxf(st[0][qs][2], st[0][qs][3]));
#pragma unroll
                    for (int kt = 1; kt < 4; ++kt) mx = fmaxf(mx, fmaxf(fmaxf(st[kt][qs][0], st[kt][qs][1]), fmaxf(st[kt][qs][2], st[kt][qs][3])));
                    mx = xmax_16_32(mx);
                    mrun[qs] = mx;
#pragma unroll
                    for (int kt = 0; kt < 4; ++kt) st[kt][qs] = st[kt][qs] - mx;
                }
                asm volatile("" ::: "memory");
            }
#pragma unroll
            for (int qs = 0; qs < NQS; ++qs) {
                float ps = 0.f;
#pragma unroll
                for (int kt = 0; kt < 4; ++kt)
#pragma unroll
                    for (int r = 0; r < 4; ++r) { const float pv = __builtin_amdgcn_exp2f(st[kt][qs][r]); st[kt][qs][r] = pv; ps += pv; }
                lsum[qs] += ps; psv[qs] = ps;
#pragma unroll
                for (int k2 = 0; k2 < 2; ++k2) {
                    u32x4 w; w.x = cvt_pk_bf16(st[2 * k2][qs][0], st[2 * k2][qs][1]); w.y = cvt_pk_bf16(st[2 * k2][qs][2], st[2 * k2][qs][3]);
                    w.z = cvt_pk_bf16(st[2 * k2 + 1][qs][0], st[2 * k2 + 1][qs][1]); w.w = cvt_pk_bf16(st[2 * k2 + 1][qs][2], st[2 * k2 + 1][qs][3]);
                    pb[qs][k2] = __builtin_bit_cast(bf16x8, w);
                }
            }
#pragma unroll
            for (int dt = 0; dt < 4; ++dt)
#pragma unroll
                for (int k2 = 0; k2 < 2; ++k2) {
                    const int drow = 16 * dt + c16;
                    const bf16x8 vf = *(const LAS bf16x8*)(vb + (drow * AT_VP + ((((4 * k2 + g) ^ (drow >> 3)) & 7) << 3)) * 2);
#pragma unroll
                    for (int qs = 0; qs < NQS; ++qs) o[dt][qs] = MFMA16(vf, pb[qs][k2], o[dt][qs]);
                }
            {
                bool big = false;
#pragma unroll
                for (int qs = 0; qs < NQS; ++qs) big = big || (psv[qs] > 65536.0f);
                if (__any(big)) {
#pragma unroll
                    for (int qs = 0; qs < NQS; ++qs) {
                        const float rs = xsum_16_32(psv[qs]);
                        const float dl = rs > 65536.0f ? floorf(__builtin_amdgcn_logf(rs)) : 0.f;
                        const float alpha = __builtin_amdgcn_exp2f(-dl);
                        mrun[qs] += dl; lsum[qs] *= alpha;
#pragma unroll
                        for (int dt = 0; dt < 4; ++dt) o[dt][qs] = o[dt][qs] * alpha;
                    }
                }
            }
        }
        if (t + 2 < NT) AT_STORE((t + 2) & 3);
        if (t & 1) __syncthreads();
    }
    __syncthreads();
    if (active) {
#pragma unroll
        for (int qs = 0; qs < NQS; ++qs) {
            const float ls = xsum_16_32(lsum[qs]);
            const float inv = __builtin_amdgcn_rcpf(ls);
            const int qr = q0 + 16 * qs + c16;
            if (qr < Lseq) {
#pragma unroll
                for (int dt = 0; dt < 4; ++dt) {
                    u32x2 w; w.x = cvt_pk_bf16(o[dt][qs][0] * inv, o[dt][qs][1] * inv); w.y = cvt_pk_bf16(o[dt][qs][2] * inv, o[dt][qs][3] * inv);
                    *(u32x2*)(AO + (size_t)(sb + qr) * 512 + head * 64 + 16 * dt + 4 * g) = w;
                }
            }
        }
    }
#undef AT_LOAD
#undef AT_STORE
}

__device__ __forceinline__ void attn_unit_p(const Params& P, LAS unsigned char* L, int seq, int head, int qrow0) {
    constexpr int NQS = 2;
    int tid_ = threadIdx.x; asm volatile("" : "+v"(tid_));
    const int tid = tid_, lane = tid & 63, wid = __builtin_amdgcn_readfirstlane(tid >> 6), g = lane >> 4, c16 = lane & 15;
    const int Lseq = seq < 32 ? L_P : L_S, sb = seq < 32 ? seq * L_P : M_P;
    const int NT = (Lseq + 63) >> 6;
    unsigned char* ws = P.ws;
    const bf16_t* Qg = (const bf16_t*)(ws + WS_Q); const bf16_t* KVg = (const bf16_t*)(ws + WS_KV); const bf16_t* KRg = (const bf16_t*)(ws + WS_KR);
    bf16_t* AO = (bf16_t*)(ws + WS_AO);
    const int skey = tid >> 3, sc = tid & 7;
    const int vpos = (skey & 32) | (((skey >> 2) & 3) << 3) | (((skey >> 4) & 1) << 2) | (skey & 3);
    const int vcol = ((((vpos >> 3) ^ sc) & 7) << 3) | (vpos & 7);
    const bf16_t* gk = KVg + (size_t)(sb + skey) * 1024 + head * 128 + 8 * sc;
    const bf16_t* gr = KRg + (size_t)(sb + skey) * 32 + 4 * sc;
    u32x4 rkA, rvA, rkB, rvB; u32x2 rrA, rrB;
#define AP_LOADK(X, t) do { rk##X = *(const u32x4*)(gk + (size_t)(t) * 64 * 1024); rr##X = *(const u32x2*)(gr + (size_t)(t) * 64 * 32); } while (0)
#define AP_LOADV(X, t) do { rv##X = *(const u32x4*)(gk + 64 + (size_t)(t) * 64 * 1024); } while (0)
#define AP_STOREK(X, slot) do { LAS unsigned char* kb_ = L + (slot) * AT_KBUF; *(LAS u32x4*)(kb_ + (skey * AT_KP + 8 * sc) * 2) = rk##X; *(LAS u32x2*)(kb_ + (skey * AT_KP + 64 + 4 * sc) * 2) = rr##X; } while (0)
#define AP_STOREV(X, slot) do { const u32x4 rv = rv##X; LAS bf16_t* vt_ = (LAS bf16_t*)(L + AT_VOFF + (slot) * AT_VBUF) + (8 * sc) * AT_VP + vcol; \
        vt_[0 * AT_VP] = (bf16_t)(rv.x & 0xffffu); vt_[1 * AT_VP] = (bf16_t)(rv.x >> 16); vt_[2 * AT_VP] = (bf16_t)(rv.y & 0xffffu); vt_[3 * AT_VP] = (bf16_t)(rv.y >> 16); \
        vt_[4 * AT_VP] = (bf16_t)(rv.z & 0xffffu); vt_[5 * AT_VP] = (bf16_t)(rv.z >> 16); vt_[6 * AT_VP] = (bf16_t)(rv.w & 0xffffu); vt_[7 * AT_VP] = (bf16_t)(rv.w >> 16); } while (0)
    const int q0 = qrow0 + wid * 16 * NQS;
    const bool active = q0 < Lseq;
    bf16x8 qf[NQS][3];
#pragma unroll
    for (int qs = 0; qs < NQS; ++qs) {
        int qr = q0 + 16 * qs + c16; qr = qr < Lseq ? qr : Lseq - 1;
#pragma unroll
        for (int ks = 0; ks < 3; ++ks) qf[qs][ks] = *(const bf16x8*)(Qg + (size_t)(sb + qr) * 768 + head * 96 + 32 * ks + 8 * g);
        {
            const u32x4 own = __builtin_bit_cast(u32x4, qf[qs][2]);
            u32x4 oth; oth.x = __shfl_xor(own.x, 32); oth.y = __shfl_xor(own.y, 32); oth.z = __shfl_xor(own.z, 32); oth.w = __shfl_xor(own.w, 32);
            const float* ct = (const float*)(ws + WS_COS) + qr * 16 + 8 * (g & 1); const float* sn = (const float*)(ws + WS_SIN) + qr * 16 + 8 * (g & 1);
            const f32x4 c0 = *(const f32x4*)ct, c1 = *(const f32x4*)(ct + 4), s0 = *(const f32x4*)sn, s1 = *(const f32x4*)(sn + 4);
            const float sg = (g < 2) ? -1.f : 1.f;
            u32x4 r;
            r.x = cvt_pk_bf16(bf_lo(own.x) * c0[0] + sg * bf_lo(oth.x) * s0[0], bf_hi(own.x) * c0[1] + sg * bf_hi(oth.x) * s0[1]);
            r.y = cvt_pk_bf16(bf_lo(own.y) * c0[2] + sg * bf_lo(oth.y) * s0[2], bf_hi(own.y) * c0[3] + sg * bf_hi(oth.y) * s0[3]);
            r.z = cvt_pk_bf16(bf_lo(own.z) * c1[0] + sg * bf_lo(oth.z) * s1[0], bf_hi(own.z) * c1[1] + sg * bf_hi(oth.z) * s1[1]);
            r.w = cvt_pk_bf16(bf_lo(own.w) * c1[2] + sg * bf_lo(oth.w) * s1[2], bf_hi(own.w) * c1[3] + sg * bf_hi(oth.w) * s1[3]);
            qf[qs][2] = __builtin_bit_cast(bf16x8, r);
        }
    }
    f32x4 o[4][NQS]; float mrun[NQS], lsum[NQS], mxs[NQS], psv[NQS];
#pragma unroll
    for (int qs = 0; qs < NQS; ++qs) { mrun[qs] = 0.f; lsum[qs] = 0.f; mxs[qs] = 0.f; psv[qs] = 0.f;
#pragma unroll
        for (int dt = 0; dt < 4; ++dt) o[dt][qs] = (f32x4){0.f, 0.f, 0.f, 0.f}; }
    f32x4 stA[4][NQS], stB[4][NQS]; bf16x8 pb[NQS][2];
#define AP_QK(S, tt) do { const LAS unsigned char* kb = L + ((tt) & 1) * AT_KBUF; \
        _Pragma("unroll") for (int kt = 0; kt < 4; ++kt) { \
            _Pragma("unroll") for (int qs = 0; qs < NQS; ++qs) { const float nm = -mrun[qs]; S[kt][qs] = (f32x4){nm, nm, nm, nm}; } \
            _Pragma("unroll") for (int ks = 0; ks < 3; ++ks) { \
                const bf16x8 kf = *(const LAS bf16x8*)(kb + ((16 * kt + c16) * AT_KP + 32 * ks + 8 * g) * 2); \
                _Pragma("unroll") for (int qs = 0; qs < NQS; ++qs) S[kt][qs] = MFMA16(kf, qf[qs][ks], S[kt][qs]); } } \
        if ((tt) == NT - 1) { \
            _Pragma("unroll") for (int kt = 0; kt < 4; ++kt) _Pragma("unroll") for (int r = 0; r < 4; ++r) if (64 * (tt) + 16 * kt + 4 * g + r >= Lseq) { \
                _Pragma("unroll") for (int qs = 0; qs < NQS; ++qs) S[kt][qs][r] = -INFINITY; } } } while (0)
#define AP_ROWMAX(S) do { _Pragma("unroll") for (int qs = 0; qs < NQS; ++qs) { \
            float mx = fmaxf(fmaxf(S[0][qs][0], S[0][qs][1]), fmaxf(S[0][qs][2], S[0][qs][3])); \
            _Pragma("unroll") for (int kt = 1; kt < 4; ++kt) mx = fmaxf(mx, fmaxf(fmaxf(S[kt][qs][0], S[kt][qs][1]), fmaxf(S[kt][qs][2], S[kt][qs][3]))); \
            mxs[qs] = xmax_16_32(mx); } } while (0)
#define AP_GROW(S, tt) do { bool grow = ((tt) == 0); \
        _Pragma("unroll") for (int qs = 0; qs < NQS; ++qs) grow = grow || (mxs[qs] > 8.0f); \
        if (__any(grow)) { \
            _Pragma("unroll") for (int qs = 0; qs < NQS; ++qs) { \
                const float dl = ((tt) == 0) ? mxs[qs] : fmaxf(mxs[qs], 0.f); \
                const float alpha = __builtin_amdgcn_exp2f(-dl); \
                mrun[qs] += dl; lsum[qs] *= alpha; \
                _Pragma("unroll") for (int kt = 0; kt < 4; ++kt) S[kt][qs] = S[kt][qs] - dl; \
                _Pragma("unroll") for (int dt = 0; dt < 4; ++dt) o[dt][qs] = o[dt][qs] * alpha; } } } while (0)
#define AP_EXP(S) do { _Pragma("unroll") for (int qs = 0; qs < NQS; ++qs) { \
            float ps = 0.f; \
            _Pragma("unroll") for (int kt = 0; kt < 4; ++kt) _Pragma("unroll") for (int r = 0; r < 4; ++r) { const float pv = __builtin_amdgcn_exp2f(S[kt][qs][r]); S[kt][qs][r] = pv; ps += pv; } \
            lsum[qs] += ps; psv[qs] = ps; \
            _Pragma("unroll") for (int k2 = 0; k2 < 2; ++k2) { \
                u32x4 w; w.x = cvt_pk_bf16(S[2 * k2][qs][0], S[2 * k2][qs][1]); w.y = cvt_pk_bf16(S[2 * k2][qs][2], S[2 * k2][qs][3]); \
                w.z = cvt_pk_bf16(S[2 * k2 + 1][qs][0], S[2 * k2 + 1][qs][1]); w.w = cvt_pk_bf16(S[2 * k2 + 1][qs][2], S[2 * k2 + 1][qs][3]); \
                pb[qs][k2] = __builtin_bit_cast(bf16x8, w); } } } while (0)
#define AP_PV(tt) do { const LAS unsigned char* vb = L + AT_VOFF + ((tt) & 1) * AT_VBUF; \
        _Pragma("unroll") for (int dt = 0; dt < 4; ++dt) _Pragma("unroll") for (int k2 = 0; k2 < 2; ++k2) { \
            const int drow = 16 * dt + c16; \
            const bf16x8 vf = *(const LAS bf16x8*)(vb + (drow * AT_VP + ((((4 * k2 + g) ^ (drow >> 3)) & 7) << 3)) * 2); \
            _Pragma("unroll") for (int qs = 0; qs < NQS; ++qs) o[dt][qs] = MFMA16(vf, pb[qs][k2], o[dt][qs]); } } while (0)
#define AP_LAZY(NXT) do { bool big = false; \
        _Pragma("unroll") for (int qs = 0; qs < NQS; ++qs) big = big || (psv[qs] > 65536.0f); \
        if (__any(big)) { \
            _Pragma("unroll") for (int qs = 0; qs < NQS; ++qs) { \
                const float rs = xsum_16_32(psv[qs]); \
                const float dl = rs > 65536.0f ? floorf(__builtin_amdgcn_logf(rs)) : 0.f; \
                const float alpha = __builtin_amdgcn_exp2f(-dl); \
                mrun[qs] += dl; lsum[qs] *= alpha; \
                _Pragma("unroll") for (int kt = 0; kt < 4; ++kt) NXT[kt][qs] = NXT[kt][qs] - dl; \
                _Pragma("unroll") for (int dt = 0; dt < 4; ++dt) o[dt][qs] = o[dt][qs] * alpha; } } } while (0)
#define AP_STEP(CUR, NXT, LD, ST, t) do { \
        if ((t) + 3 < NT) AP_LOADK(LD, (t) + 3); \
        if ((t) + 2 < NT) AP_LOADV(LD, (t) + 2); \
        if (active) { \
            if ((t) + 1 < NT) { AP_QK(NXT, (t) + 1); } \
            AP_EXP(CUR); \
            AP_PV(t); \
            if ((t) + 1 < NT) { AP_LAZY(NXT); } \
        } \
        if ((t) + 2 < NT) AP_STOREK(ST, (t) & 1); \
        if ((t) + 1 < NT) AP_STOREV(ST, ((t) + 1) & 1); \
        __syncthreads(); } while (0)
    AP_LOADK(A, 0); AP_LOADV(A, 0); AP_STOREK(A, 0); AP_STOREV(A, 0);
    AP_LOADK(A, 1); AP_STOREK(A, 1);
    AP_LOADK(B, 2); AP_LOADV(B, 1);
    __syncthreads();
    if (active) { AP_QK(stA, 0); AP_ROWMAX(stA);
#pragma unroll
        for (int qs = 0; qs < NQS; ++qs) { mrun[qs] = mxs[qs];
#pragma unroll
            for (int kt = 0; kt < 4; ++kt) stA[kt][qs] = stA[kt][qs] - mxs[qs]; } }
    __syncthreads();
    int t = 0;
    for (; t + 1 < NT; t += 2) { AP_STEP(stA, stB, A, B, t); AP_STEP(stB, stA, B, A, t + 1); }
    if (t < NT) { AP_STEP(stA, stB, A, B, t); }
    if (active) {
#pragma unroll
        for (int qs = 0; qs < NQS; ++qs) {
            const float ls = xsum_16_32(lsum[qs]);
            const float inv = __builtin_amdgcn_rcpf(ls);
            const int qr = q0 + 16 * qs + c16;
            if (qr < Lseq) {
#pragma unroll
                for (int dt = 0; dt < 4; ++dt) {
                    u32x2 w; w.x = cvt_pk_bf16(o[dt][qs][0] * inv, o[dt][qs][1] * inv); w.y = cvt_pk_bf16(o[dt][qs][2] * inv, o[dt][qs][3] * inv);
                    *(u32x2*)(AO + (size_t)(sb + qr) * 512 + head * 64 + 16 * dt + 4 * g) = w;
                }
            }
        }
    }
#undef AP_LOADK
#undef AP_LOADV
#undef AP_STOREK
#undef AP_STOREV
#undef AP_QK
#undef AP_ROWMAX
#undef AP_GROW
#undef AP_LAZY
#undef AP_EXP
#undef AP_PV
#undef AP_STEP
}

constexpr int ML_QP = 136, ML_SP = 72;
constexpr int ML_QS = 0, ML_KS = 64 * ML_QP * 2, ML_KWT = ML_KS + 64 * ML_QP * 2, ML_VT = ML_KWT + 128 * ML_SP * 2, ML_CB = ML_VT + 144 * ML_SP * 2,
              ML_SB = ML_CB + 144 * ML_QP * 2, ML_DEN = ML_SB + 64 * ML_SP * 2, ML_END = ML_DEN + 256;
static_assert(ML_END <= 131072, "mlstm lds");
__device__ __forceinline__ void mlstm_unit(const Params& P, LAS unsigned char* L, int seq, int hd, int dir) {
    int tid_ = threadIdx.x; asm volatile("" : "+v"(tid_));
    const int tid = tid_, lane = tid & 63, wid = __builtin_amdgcn_readfirstlane(tid >> 6), g = lane >> 4, c16 = lane & 15;
    const int Lseq = seq < 32 ? L_P : L_S, sb = seq < 32 ? seq * L_P : M_P;
    const int NC = (Lseq + 48) >> 6;
    unsigned char* ws = P.ws;
    const bf16_t* Z1 = (const bf16_t*)(ws + WS_R1);
    const float* GI = (const float*)(ws + WS_GI); const float* LF = (const float*)(ws + WS_LF);
    bf16_t* HP = (bf16_t*)(ws + (dir ? WS_HB : WS_HF));
    LAS bf16_t* Qs = (LAS bf16_t*)(L + ML_QS); LAS bf16_t* Ks = (LAS bf16_t*)(L + ML_KS); LAS bf16_t* KwT = (LAS bf16_t*)(L + ML_KWT);
    LAS bf16_t* VT = (LAS bf16_t*)(L + ML_VT); LAS bf16_t* Cb = (LAS bf16_t*)(L + ML_CB); LAS bf16_t* Sb = (LAS bf16_t*)(L + ML_SB);
    LAS float* DEN = (LAS float*)(L + ML_DEN);
    for (int i = tid; i < 16 * ML_SP; i += 512) VT[128 * ML_SP + i] = (i < 64) ? (bf16_t)0x3F80 : (bf16_t)0;
    for (int i = tid; i < 144 * ML_QP / 2; i += 512) ((LAS unsigned*)Cb)[i] = 0u;
    f32x4 Cacc[9];
#pragma unroll
    for (int e = 0; e < 9; ++e) Cacc[e] = (f32x4){0.f, 0.f, 0.f, 0.f};
    float mstate = -1e30f;
    const int sj = tid >> 4, scx = tid & 15, d0 = 8 * scx;
    u32x4 pq[2], pk[2], pv[2]; float pgi, plf;
#define ML_TOK(c_, j_) (dir ? (64 * (c_) + 15 - (j_)) : (64 * (c_) - 48 + (j_)))
#define ML_PREFETCH(step_) do { const int c_ = dir ? (NC - 1 - (step_)) : (step_); \
        { const int l_ = ML_TOK(c_, lane); const size_t r_ = (size_t)(sb + (l_ >= 0 ? l_ : 0)); pgi = l_ >= 0 ? GI[r_ * 8 + dir * 4 + hd] : -1e30f; plf = l_ >= 0 ? LF[r_ * 8 + dir * 4 + hd] : 0.f; } \
        _Pragma("unroll") for (int i2 = 0; i2 < 2; ++i2) { const int l_ = ML_TOK(c_, sj + 32 * i2); \
            const bf16_t* zp_ = Z1 + (size_t)(sb + (l_ >= 0 ? l_ : 0)) * ZW + 512 + hd * 128 + d0; \
            if (l_ >= 0) { pq[i2] = *(const u32x4*)zp_; pk[i2] = *(const u32x4*)(zp_ + 512); pv[i2] = *(const u32x4*)(zp_ + 1024); } \
            else { pq[i2] = (u32x4){0u, 0u, 0u, 0u}; pk[i2] = pq[i2]; pv[i2] = pq[i2]; } } } while (0)
    ML_PREFETCH(0);
    __syncthreads();
    f32x4 a1[4], a2[4]; float Mt_o = 0.f, b_o = 0.f, ms_o = 0.f; int ls_o = -1;
    const int swzw = (2 * wid + (c16 >> 3)) & 7;
#define ML_OUTPUT() do { _Pragma("unroll") for (int tt = 0; tt < 4; ++tt) { \
            const int tl = 16 * tt + c16; \
            const float Mt_t = __shfl(Mt_o, tl), b_t = __shfl(b_o, tl); \
            const int l_t = __shfl(ls_o, tl); \
            const float et = __expf(ms_o - Mt_t), fl = __expf(-(b_t + Mt_t)); \
            const float den = DEN[tl]; \
            const float inv = __builtin_amdgcn_rcpf(fmaxf(fabsf(den), fl)); \
            if (l_t >= 0) { \
                u32x2 w; w.x = cvt_pk_bf16((a1[tt][0] + et * a2[tt][0]) * inv, (a1[tt][1] + et * a2[tt][1]) * inv); \
                w.y = cvt_pk_bf16((a1[tt][2] + et * a2[tt][2]) * inv, (a1[tt][3] + et * a2[tt][3]) * inv); \
                *(u32x2*)(HP + (size_t)(sb + l_t) * 512 + hd * 128 + 16 * wid + 4 * g) = w; } } } while (0)
    for (int step = 0; step < NC; ++step) {
        const int c = dir ? (NC - 1 - step) : step;
        const int ls = ML_TOK(c, lane);
        const float gi = pgi, lf = plf;
        const float b = wave_scan_sum(lf, lane);
        const float gtot = __int_as_float(__builtin_amdgcn_readlane(__float_as_int(b), 63));
        const float uu = gi - b;
        const float pm = wave_scan_max(uu, lane);
        const float pm63 = __int_as_float(__builtin_amdgcn_readlane(__float_as_int(pm), 63));
        const float mloc = gtot + pm63;
        const float Mt = fmaxf(pm, mstate);
        const float mnew = fmaxf(gtot + mstate, mloc);
        const float sp = __expf(gtot + mstate - mnew), sl = __expf(mloc - mnew);
        const float wsl = __expf(uu - pm63) * sl;
        if (step > 0) ML_OUTPUT();
#pragma unroll
        for (int i2 = 0; i2 < 2; ++i2) {
            const int j = sj + 32 * i2;
            const float wj = __shfl(wsl, j);
            *(LAS u32x4*)(Qs + j * ML_QP + d0) = pq[i2];
            *(LAS u32x4*)(Ks + j * ML_QP + d0) = pk[i2];
            const int col = ((((j >> 3) ^ scx) & 7) << 3) | (j & 7);
            LAS bf16_t* kw = KwT + d0 * ML_SP + col; LAS bf16_t* vt = VT + d0 * ML_SP + col;
            const unsigned kk[4] = {pk[i2].x, pk[i2].y, pk[i2].z, pk[i2].w}, vv[4] = {pv[i2].x, pv[i2].y, pv[i2].z, pv[i2].w};
#pragma unroll
            for (int e = 0; e < 4; ++e) {
                const unsigned pkd = cvt_pk_bf16(bf_lo(kk[e]) * wj, bf_hi(kk[e]) * wj);
                kw[(2 * e) * ML_SP] = (bf16_t)(pkd & 0xffffu); kw[(2 * e + 1) * ML_SP] = (bf16_t)(pkd >> 16);
                vt[(2 * e) * ML_SP] = (bf16_t)(vv[e] & 0xffffu); vt[(2 * e + 1) * ML_SP] = (bf16_t)(vv[e] >> 16);
            }
        }
        if (step + 1 < NC) ML_PREFETCH(step + 1);
        __syncthreads();
        {
            const int tt = wid >> 1;
            const float Mt_t = __shfl(Mt, 16 * tt + c16);
#pragma unroll
            for (int sti = 0; sti < 2; ++sti) {
                const int stile = 2 * (wid & 1) + sti;
                f32x4 a = {0.f, 0.f, 0.f, 0.f};
                if (stile <= tt) {
#pragma unroll
                    for (int ks = 0; ks < 4; ++ks) {
                        const bf16x8 kf = *(const LAS bf16x8*)(Ks + (16 * stile + c16) * ML_QP + 32 * ks + 8 * g);
                        const bf16x8 qf = *(const LAS bf16x8*)(Qs + (16 * tt + c16) * ML_QP + 32 * ks + 8 * g);
                        a = MFMA16(kf, qf, a);
                    }
                }
                float vals[4];
#pragma unroll
                for (int r = 0; r < 4; ++r) {
                    const int si = 16 * stile + 4 * g + r;
                    const float us = __shfl(uu, si);
                    vals[r] = (si <= 16 * tt + c16) ? a[r] * __expf(us - Mt_t) : 0.f;
                }
                u32x2 w; w.x = cvt_pk_bf16(vals[0], vals[1]); w.y = cvt_pk_bf16(vals[2], vals[3]);
                *(LAS u32x2*)(Sb + (16 * tt + c16) * ML_SP + 16 * stile + 4 * g) = w;
            }
        }
#pragma unroll
        for (int tt = 0; tt < 4; ++tt) {
            a2[tt] = (f32x4){0.f, 0.f, 0.f, 0.f};
#pragma unroll
            for (int ks = 0; ks < 4; ++ks) {
                const bf16x8 cf = *(const LAS bf16x8*)(Cb + (16 * wid + c16) * ML_QP + 32 * ks + 8 * g);
                const bf16x8 qf = *(const LAS bf16x8*)(Qs + (16 * tt + c16) * ML_QP + 32 * ks + 8 * g);
                a2[tt] = MFMA16(cf, qf, a2[tt]);
            }
        }
        f32x4 d2 = {0.f, 0.f, 0.f, 0.f};
        if (wid < 4) {
#pragma unroll
            for (int ks = 0; ks < 4; ++ks) {
                const bf16x8 cf = *(const LAS bf16x8*)(Cb + (128 + c16) * ML_QP + 32 * ks + 8 * g);
                const bf16x8 qf = *(const LAS bf16x8*)(Qs + (16 * wid + c16) * ML_QP + 32 * ks + 8 * g);
                d2 = MFMA16(cf, qf, d2);
            }
        }
        __syncthreads();
#pragma unroll
        for (int tt = 0; tt < 4; ++tt) {
            a1[tt] = (f32x4){0.f, 0.f, 0.f, 0.f};
#pragma unroll
            for (int k2 = 0; k2 < 2; ++k2) {
                const bf16x8 vf = *(const LAS bf16x8*)(VT + (16 * wid + c16) * ML_SP + (((4 * k2 + g) ^ swzw) << 3));
                const bf16x8 sf = *(const LAS bf16x8*)(Sb + (16 * tt + c16) * ML_SP + 32 * k2 + 8 * g);
                a1[tt] = MFMA16(vf, sf, a1[tt]);
            }
        }
        if (wid < 4) {
            f32x4 d1 = {0.f, 0.f, 0.f, 0.f};
#pragma unroll
            for (int k2 = 0; k2 < 2; ++k2) {
                const bf16x8 vf = *(const LAS bf16x8*)(VT + (128 + c16) * ML_SP + (((4 * k2 + g) ^ (c16 >> 3)) << 3));
                const bf16x8 sf = *(const LAS bf16x8*)(Sb + (16 * wid + c16) * ML_SP + 32 * k2 + 8 * g);
                d1 = MFMA16(vf, sf, d1);
            }
            const float et = __expf(mstate - __shfl(Mt, 16 * wid + c16));
            if (g == 0) DEN[16 * wid + c16] = d1[0] + et * d2[0];
        }
        {
            bf16x8 kf[2];
#pragma unroll
            for (int k2 = 0; k2 < 2; ++k2) kf[k2] = *(const LAS bf16x8*)(KwT + (16 * wid + c16) * ML_SP + (((4 * k2 + g) ^ swzw) << 3));
#pragma unroll
            for (int et = 0; et < 9; ++et) {
                f32x4 cc = Cacc[et] * sp;
                const int swze = (2 * et + (c16 >> 3)) & 7;
#pragma unroll
                for (int k2 = 0; k2 < 2; ++k2) {
                    const bf16x8 vf = *(const LAS bf16x8*)(VT + (16 * et + c16) * ML_SP + (((4 * k2 + g) ^ swze) << 3));
                    cc = MFMA16(kf[k2], vf, cc);
                }
                Cacc[et] = cc;
                u32x2 w; w.x = cvt_pk_bf16(cc[0], cc[1]); w.y = cvt_pk_bf16(cc[2], cc[3]);
                *(LAS u32x2*)(Cb + (16 * et + c16) * ML_QP + 16 * wid + 4 * g) = w;
            }
        }
        Mt_o = Mt; b_o = b; ls_o = ls; ms_o = mstate;
        mstate = mnew;
        __syncthreads();
    }
    ML_OUTPUT();
    __syncthreads();
#undef ML_OUTPUT
#undef ML_TOK
#undef ML_PREFETCH
}

#ifndef ATT_PIPE
#define ATT_PIPE 0
#endif
#if ATT_PIPE
constexpr int Q_SML = 8, Q_PML = 256, Q_ML = Q_SML + Q_PML, Q_SAT = 8 * 65, Q_PAT = 32 * 8 * 9, Q_PRM = 0, Q_AT = Q_SAT + Q_PAT;
#else
constexpr int Q_SML = 8, Q_PML = 256, Q_ML = Q_SML + Q_PML, Q_SAT = 8 * 43, Q_PAT = 32 * 8 * 5, Q_PRM = 256, Q_AT = Q_SAT + Q_PAT + Q_PRM;
#endif
__device__ __forceinline__ void phase_mixers(const Params& P, LAS unsigned char* lds, int rep, int pflag) {
    LAS int* qw = (LAS int*)(lds + 131072);
    unsigned* ctr = (unsigned*)(P.ws + WS_CTL) + 2 * rep;
    if (!(pflag & 2)) for (;;) {
        if (threadIdx.x == 0) qw[0] = (int)atomicAdd(ctr, 1u);
        __syncthreads();
        int idx = __builtin_amdgcn_readfirstlane(qw[0]);
        __syncthreads();
        if (idx >= Q_ML) break;
        if (idx < Q_SML) { mlstm_unit(P, lds, 32, idx >> 1, idx & 1); continue; } idx -= Q_SML;
        mlstm_unit(P, lds, idx >> 3, (idx >> 1) & 3, idx & 1);
    }
    if (!(pflag & 1)) for (;;) {
        if (threadIdx.x == 0) qw[0] = (int)atomicAdd(ctr + 1, 1u);
        __syncthreads();
        int idx = __builtin_amdgcn_readfirstlane(qw[0]);
        __syncthreads();
        if (idx >= Q_AT) break;
        int sq, hh, r0;
        if (idx < Q_SAT) { sq = 32; hh = idx / 43; r0 = (idx % 43) * 384; }
        else if (idx < Q_SAT + Q_PAT) { idx -= Q_SAT; const int sh = idx / 5; sq = sh >> 3; hh = sh & 7; r0 = (idx % 5) * 384; }
        else { idx -= Q_SAT + Q_PAT; sq = idx >> 3; hh = idx & 7; r0 = 1920; }
        attn_unit<3>(P, lds, sq, hh, r0, pflag & 4);
    }
}

__device__ __forceinline__ void phase_hm_final(const Params& P, LAS unsigned char* lds) {
    const int tid = threadIdx.x, lane = tid & 63, wid = tid >> 6;
    const int gw = blockIdx.x * 8 + wid, NGW = gridDim.x * 8;
    unsigned char* ws = P.ws;
    bf16_t* HF = (bf16_t*)(ws + WS_HF); const bf16_t* HB = (const bf16_t*)(ws + WS_HB); const bf16_t* Z1 = (const bf16_t*)(ws + WS_R1);
    const float* mn = P.in[I_MN];
    const f32x4 g0 = *(const f32x4*)(mn + 8 * lane), g1 = *(const f32x4*)(mn + 8 * lane + 4);
    const float gg[8] = {g0.x, g0.y, g0.z, g0.w, g1.x, g1.y, g1.z, g1.w};
    LAS int* qw = (LAS int*)(lds + 131072);
    unsigned* ctr = (unsigned*)(ws + WS_CTL) + 4;
    for (;;) {
      if (tid == 0) qw[0] = (int)atomicAdd(ctr, 1u);
      __syncthreads();
      const int ch = __builtin_amdgcn_readfirstlane(qw[0]);
      __syncthreads();
      if (ch >= MP / 64) break;
      for (int it = 0; it < 4; ++it) {
        const int m0 = ch * 64 + wid * 8 + 2 * it; const int NGW1 = 1;
        u32x4 av[2], bv[2], ov[2];
#pragma unroll
        for (int h = 0; h < 2; ++h) {
            int m = m0 + h * NGW1; m = m < M_TOK ? m : 0;
            av[h] = *(const u32x4*)(HF + (size_t)m * 512 + 8 * lane); bv[h] = *(const u32x4*)(HB + (size_t)m * 512 + 8 * lane); ov[h] = *(const u32x4*)(Z1 + (size_t)m * ZW + 2048 + 8 * lane);
        }
#pragma unroll
        for (int h = 0; h < 2; ++h) {
            const int m = m0 + h * NGW1; if (m >= MP) continue;
            u32x4* hp = (u32x4*)(HF + (size_t)m * 512 + 8 * lane);
            if (m >= M_TOK) { *hp = (u32x4){0u, 0u, 0u, 0u}; continue; }
            const u32x4 a = av[h], b = bv[h], o = ov[h];
            float v[8] = {bf_lo(a.x) + bf_lo(b.x), bf_hi(a.x) + bf_hi(b.x), bf_lo(a.y) + bf_lo(b.y), bf_hi(a.y) + bf_hi(b.y),
                          bf_lo(a.z) + bf_lo(b.z), bf_hi(a.z) + bf_hi(b.z), bf_lo(a.w) + bf_lo(b.w), bf_hi(a.w) + bf_hi(b.w)};
            const float og[8] = {bf_lo(o.x), bf_hi(o.x), bf_lo(o.y), bf_hi(o.y), bf_lo(o.z), bf_hi(o.z), bf_lo(o.w), bf_hi(o.w)};
            float sq = 0.f;
#pragma unroll
            for (int i = 0; i < 8; ++i) sq += v[i] * v[i];
            sq += __shfl_xor(sq, 1); sq += __shfl_xor(sq, 2); sq += __shfl_xor(sq, 4); sq += __shfl_xor(sq, 8);
            const float rstd = rsqrt_(sq * (1.f / 128.f) + EPS);
#pragma unroll
            for (int i = 0; i < 8; ++i) v[i] = v[i] * rstd * gg[i] * sigmoidf_(og[i]);
            u32x4 w; w.x = cvt_pk_bf16(v[0], v[1]); w.y = cvt_pk_bf16(v[2], v[3]); w.z = cvt_pk_bf16(v[4], v[5]); w.w = cvt_pk_bf16(v[6], v[7]);
            *hp = w;
        }
      }
    }
}
__device__ __forceinline__ void phase_rstd2(const Params& P) {
    const int tid = threadIdx.x, lane = tid & 63, wid = tid >> 6;
    const int gw = blockIdx.x * 8 + wid, NGW = gridDim.x * 8;
    const bf16_t* H1 = (const bf16_t*)(P.ws + WS_AO); float* rs2 = (float*)(P.ws + WS_RS2);
    for (int m = gw; m < M_TOK; m += NGW) {
        const u32x4 a = *(const u32x4*)(H1 + (size_t)m * DM + 8 * lane), b = *(const u32x4*)(H1 + (size_t)m * DM + 512 + 8 * lane);
        float s = bf_lo(a.x) * bf_lo(a.x) + bf_hi(a.x) * bf_hi(a.x) + bf_lo(a.y) * bf_lo(a.y) + bf_hi(a.y) * bf_hi(a.y) + bf_lo(a.z) * bf_lo(a.z) + bf_hi(a.z) * bf_hi(a.z) + bf_lo(a.w) * bf_lo(a.w) + bf_hi(a.w) * bf_hi(a.w);
        s += bf_lo(b.x) * bf_lo(b.x) + bf_hi(b.x) * bf_hi(b.x) + bf_lo(b.y) * bf_lo(b.y) + bf_hi(b.y) * bf_hi(b.y) + bf_lo(b.z) * bf_lo(b.z) + bf_hi(b.z) * bf_hi(b.z) + bf_lo(b.w) * bf_lo(b.w) + bf_hi(b.w) * bf_hi(b.w);
        s = wave_sum(s);
        if (lane == 0) rs2[m] = 1.0f / sqrtf(s * (1.f / DM) + EPS);
    }
}
__device__ __forceinline__ void phase_final_norm(const Params& P) {
    const float* gf = P.in[I_NFIN]; const float* ssq = (const float*)(P.ws + WS_RSQ);
    const size_t n4 = (size_t)(NB_P * S_P + 16384) * (DM / 4);
    for (size_t i = (size_t)blockIdx.x * 512 + threadIdx.x; i < n4; i += (size_t)gridDim.x * 512) {
        const int row = (int)(i >> 8), c4 = (int)(i & 255);
        const float rstd = 1.0f / sqrtf(ssq[row] * (1.f / DM) + EPS);
        const u32x2 hw = ((const u32x2*)(P.ws + WS_KV))[i];
        const f32x4 hv = {bf_lo(hw.x), bf_hi(hw.x), bf_lo(hw.y), bf_hi(hw.y)};
        ((f32x4*)P.out)[i] = hv * rstd * ((const f32x4*)gf)[c4];
    }
}

#define XB_TMO      128
#define XB_XCNT(j)  (256  + 64 * (j))
#define XB_XSUB(j)  (1280 + 64 * (j))
#define XB_XGEN(j)  (2304 + 64 * (j))
#define XB_TOP      3328
#define XB_TOPGEN   3392
#define XCD_BAR_WORDS 3456
#define XB_SPIN_CAP (1u << 18)

__device__ __forceinline__ unsigned xb_ld(unsigned* p)              { return __hip_atomic_load(p, __ATOMIC_RELAXED, __HIP_MEMORY_SCOPE_AGENT); }
__device__ __forceinline__ unsigned xb_add(unsigned* p, unsigned v) { return __hip_atomic_fetch_add(p, v, __ATOMIC_RELAXED, __HIP_MEMORY_SCOPE_AGENT); }
__device__ __forceinline__ unsigned xb_xcc_id() { return (unsigned)__builtin_amdgcn_s_getreg((3 << 11) | 20) & 0xFu; }
#define XB_SPIN(cond, bar) do { unsigned _sp = 0; while (cond) { __builtin_amdgcn_s_sleep(1); \
    if ((++_sp & 255u) == 0u) { if (xb_ld(&(bar)[XB_TMO])) break; if (_sp > XB_SPIN_CAP) { atomicAdd(&(bar)[XB_TMO], 1u); break; } } } } while (0)

struct XcdBarrier {
    unsigned* bar; unsigned x;
    volatile LAS unsigned* st;
};

__device__ __forceinline__ XcdBarrier xcd_barrier_post(unsigned* bar, volatile LAS unsigned* st) {
    XcdBarrier b; b.bar = bar; b.x = xb_xcc_id(); b.st = st;
    if (threadIdx.x == 0) (void)xb_add(&bar[XB_XCNT(b.x)], 1u);
    return b;
}
__device__ __forceinline__ void xcd_barrier_complete(unsigned* bar, unsigned x, unsigned& nloc, unsigned& nx) {
    const unsigned G = gridDim.x * gridDim.y * gridDim.z;
    unsigned sum, cnt, mine, sp = 0u;
    for (;;) {
        sum = 0u; cnt = 0u; mine = 0u;
#pragma unroll
        for (unsigned j = 0; j < 16; ++j) { const unsigned c = xb_ld(&bar[XB_XCNT(j)]); sum += c; cnt += (c > 0u) ? 1u : 0u; mine = (j == x) ? c : mine; }
        if (sum == G) break;
        __builtin_amdgcn_s_sleep(1);
        if ((++sp & 255u) == 0u) { if (xb_ld(&bar[XB_TMO])) break; if (sp > XB_SPIN_CAP) { atomicAdd(&bar[XB_TMO], 1u); break; } }
    }
    nloc = mine > 0u ? mine : 1u; nx = cnt > 0u ? cnt : 1u;
}

__device__ __forceinline__ void xcd_barrier(const XcdBarrier& b) {
    asm volatile("s_waitcnt vmcnt(0)" ::: "memory");
    __syncthreads();
    if (threadIdx.x == 0) {
        unsigned* bar = b.bar;
        __builtin_amdgcn_s_waitcnt(0);
        unsigned nloc = b.st[0], nx = b.st[1];
        if (nloc == 0u) { xcd_barrier_complete(bar, b.x, nloc, nx); b.st[0] = nloc; b.st[1] = nx; }
        const unsigned old = xb_add(&bar[XB_XSUB(b.x)], 1u);
        const unsigned gen = old / nloc;
        if (old + 1u == (gen + 1u) * nloc) {
            __builtin_amdgcn_fence(__ATOMIC_RELEASE, "agent");
            asm volatile("s_waitcnt vmcnt(0)" ::: "memory");
            const unsigned og = xb_add(&bar[XB_TOP], 1u);
            const unsigned tg = og / nx;
            if (og + 1u == (tg + 1u) * nx) xb_add(&bar[XB_TOPGEN], 1u);
            else XB_SPIN(xb_ld(&bar[XB_TOPGEN]) == tg, bar);
            __builtin_amdgcn_fence(__ATOMIC_ACQUIRE, "agent");
            xb_add(&bar[XB_XGEN(b.x)], 1u);
            asm volatile("s_waitcnt vmcnt(0)" ::: "memory");
        } else {
            XB_SPIN(xb_ld(&bar[XB_XGEN(b.x)]) == gen, bar);
            __builtin_amdgcn_fence(__ATOMIC_ACQUIRE, "agent");
            asm volatile("s_waitcnt vmcnt(0)" ::: "memory");
        }
    }
    __syncthreads();
}

#ifndef GEMM_SP2
#define GEMM_SP2 true
#endif
constexpr int LDS_BYTES = 139264;
constexpr int N_PHASES = 13;
template <int MODE> __device__ __forceinline__ void run_gemm(LAS unsigned char* lds, const bf16_t* A, int lda, const bf16_t* Bt, int Mrows, int N, int K, const EpiG<MODE>& E) {
    pg8::Gemm g{A, Bt, Mrows, N, K, lda, 0}; pg8::StaticOrder S; S.init(Mrows, N, (int)gridDim.x, (int)blockIdx.x);
    pg8::gemm_phase<EpiG<MODE>, pg8::StaticOrder, true, GEMM_SP2>(lds, g, S, E);
}
__global__ void __launch_bounds__(512, 2) mk_fwd(Params P) {
    extern __shared__ __attribute__((aligned(16))) unsigned char lds_raw[];
    LAS unsigned char* lds = (LAS unsigned char*)lds_raw;
    unsigned char* ws = P.ws;
    const int lo = P.ph_lo, hi = P.ph_hi & 0xff, pflag = P.ph_hi >> 8;
#ifndef PHM
#define PHM 0xFFFF
#endif
#define IN(k) (((PHM >> (k)) & 1) && lo <= (k) && (k) < hi)
#if MK_MULTI_LAUNCH
#define SEAM(k) do { } while (0)
#else
#define SEAM(k) do { if (IN(k) && IN((k) + 1)) { if ((k) == 0) { asm volatile("s_waitcnt vmcnt(0)" ::: "memory"); cg::this_grid().sync(); \
        xbar = xcd_barrier_post((unsigned*)(ws + WS_CTL) + 4096, (volatile LAS unsigned*)(lds + 131072 + 64));   } \
        else { xcd_barrier(xbar); } } } while (0)
#endif
    const float* cosT = (const float*)(ws + WS_COS); const float* sinT = (const float*)(ws + WS_SIN);
    bf16_t* Z1 = (bf16_t*)(ws + WS_R1); bf16_t* U = (bf16_t*)P.out;
#if !MK_MULTI_LAUNCH
    if (threadIdx.x == 0) { ((volatile LAS unsigned*)(lds + 131072 + 64))[0] = 0u; ((volatile LAS unsigned*)(lds + 131072 + 64))[1] = 0u; }
    __syncthreads();
    XcdBarrier xbar; xbar.bar = (unsigned*)(ws + WS_CTL) + 4096; xbar.x = 0; xbar.st = (volatile LAS unsigned*)(lds + 131072 + 64);
#endif
    if (IN(0)) { phase_prologue(P, lds); } SEAM(0);
    if (IN(1)) { EpiG<EM_Z1> E{Z1, ZW, (const float*)(ws + WS_SSQQ), (const bf16_t*)(ws + WS_KR), cosT, sinT, (const float*)(ws + WS_RSKV), (const float*)(ws + WS_GI), (const float*)(ws + WS_LF), P.out, P.in[I_BI], P.in[I_BF]};
        run_gemm<EM_Z1>(lds, U, DM, (const bf16_t*)(ws + WS_BT1), MP, ZW, DM, E); } SEAM(1);
    if (IN(3)) {
        { EpiG<EM_Q> E{(bf16_t*)(ws + WS_Q), 768, (const float*)(ws + WS_SSQQ), nullptr, nullptr, nullptr, P.in[I_XP], P.in[I_XS], P.in[I_META], P.out}; run_gemm<EM_Q>(lds, Z1, ZW, (const bf16_t*)(ws + WS_WUQ), MP, 768, 256, E); }
        { EpiG<EM_KV> E{(bf16_t*)(ws + WS_KV), 1024, (const float*)(ws + WS_RSKV), nullptr, nullptr, nullptr, P.in[I_XP], P.in[I_XS], P.in[I_META], P.out}; run_gemm<EM_KV>(lds, Z1 + 256, ZW, (const bf16_t*)(ws + WS_WUKV), MP, 1024, 256, E); }
    } SEAM(3);
    if (IN(4)) { phase_mixers(P, lds, 0, pflag); } SEAM(4);
    if (IN(6)) { EpiG<EM_SIG> E{Z1, ZW, nullptr, nullptr, nullptr, nullptr, P.in[I_XP], P.in[I_XS], P.in[I_META], P.out}; run_gemm<EM_SIG>(lds, U, DM, (const bf16_t*)(ws + WS_WG), MP, 2048, DM, E); }
    if (IN(5)) { phase_hm_final(P, lds); }
    SEAM(6);
    bf16_t* Y = (bf16_t*)(ws + WS_KV);
    if (IN(7)) { EpiG<EM_MRGA> E{Y, DM, nullptr, Z1, nullptr, nullptr, P.in[I_XP], P.in[I_XS], P.in[I_META], P.out}; run_gemm<EM_MRGA>(lds, (const bf16_t*)(ws + WS_AO), 512, (const bf16_t*)(ws + WS_WOA), MP, DM, 512, E); }
    if (IN(8)) { EpiG<EM_MRGB> E{Y, DM, nullptr, Z1, nullptr, nullptr, P.in[I_XP], P.in[I_XS], P.in[I_META], P.out}; run_gemm<EM_MRGB>(lds, (const bf16_t*)(ws + WS_HF), 512, (const bf16_t*)(ws + WS_WOM), MP, DM, 512, E); } SEAM(8);
    bf16_t* H1 = (bf16_t*)(ws + WS_AO);
    if (IN(9)) { EpiG<EM_RES1> E{H1, DM, (const float*)(ws + WS_RS2), nullptr, nullptr, nullptr, P.in[I_XP], P.in[I_XS], P.in[I_META], P.out}; run_gemm<EM_RES1>(lds, Y, DM, (const bf16_t*)(ws + WS_WOUT), MP, DM, DM, E); } SEAM(9);
    bf16_t* T = (bf16_t*)(ws + WS_R1);
    if (IN(11)) {
        EpiFfn E{T, (const float*)(ws + WS_RS2), P.in[I_CW], P.in[I_CB]};
        pg8::Gemm g{H1 - DM, (const bf16_t*)(ws + WS_WFF), 333 * 256, 2 * DFF, DM, DM, 1}; pg8::StaticOrder S; S.init(333 * 256, 2 * DFF, (int)gridDim.x, (int)blockIdx.x);
        pg8::gemm_phase<EpiFfn, pg8::StaticOrder, true, GEMM_SP2>(lds, g, S, E);
    } SEAM(11);
    if (IN(12)) { EpiG<EM_DOWN> E{Y, DM, (const float*)(ws + WS_RSQ), H1, P.in[I_NFIN], (const float*)((const unsigned*)(ws + WS_CTL) + 8192), P.in[I_XP], P.in[I_XS], P.in[I_META], P.out}; run_gemm<EM_DOWN>(lds, T, DFF, (const bf16_t*)(ws + WS_WDN), NB_P * S_P + 16384, DM, DFF, E); } SEAM(12);
#undef IN
#undef SEAM
}

extern "C" void kernel_launch(void* const* d_in, const int* in_sizes, int n_in, void* d_out, int out_size, void* d_ws, size_t ws_size, hipStream_t stream) {
    static int grid = 0;
    if (grid == 0) {
        if (n_in != 22 || ws_size < WS_END) { fprintf(stderr, "kernel_launch: unexpected n_in %d or ws_size %zu (< %zu)\n", n_in, ws_size, (size_t)WS_END); grid = -1; return; }
        int dev = 0, cus = 0, per_cu = 0;
        (void)hipGetDevice(&dev); (void)hipDeviceGetAttribute(&cus, hipDeviceAttributeMultiprocessorCount, dev);
        if (hipFuncSetAttribute((const void*)mk_fwd, hipFuncAttributeMaxDynamicSharedMemorySize, LDS_BYTES) != hipSuccess) { fprintf(stderr, "kernel_launch: hipFuncSetAttribute failed\n"); grid = -1; return; }
        if (hipOccupancyMaxActiveBlocksPerMultiprocessor(&per_cu, (const void*)mk_fwd, 512, LDS_BYTES) != hipSuccess || per_cu < 1) { fprintf(stderr, "kernel_launch: occupancy query failed (%d)\n", per_cu); per_cu = 1; }
        (void)hipGetLastError();
        grid = cus * (per_cu > 1 ? 1 : per_cu);
        if (grid <= 0) grid = 256;
    }
    if (grid < 0) return;
    Params p{};
    for (int i = 0; i < 22; ++i) p.in[i] = (const float*)d_in[i];
    p.out = (float*)d_out; p.ws = (unsigned char*)d_ws;
#if MK_MULTI_LAUNCH
#ifndef DUPM
#define DUPM 0
#endif
#ifndef P4FLAG
#define P4FLAG 0
#endif
    for (int ph = 0; ph <= N_PHASES; ++ph) {
        p.ph_lo = ph; p.ph_hi = ph + 1;
        for (int rep = 0; rep < (((DUPM >> ph) & 1) ? 2 : 1); ++rep) {
            if (ph == 4 && rep > 0) { (void)hipMemsetAsync((char*)d_ws + WS_CTL, 0, 256, stream); p.ph_hi = (ph + 1) | (P4FLAG << 8); }
            hipLaunchKernelGGL(mk_fwd, dim3(grid), dim3(512), LDS_BYTES, stream, p);
        }
    }
#else
    p.ph_lo = 0; p.ph_hi = N_PHASES + 1;
    void* args[] = {&p};
    hipError_t e = hipLaunchCooperativeKernel((const void*)mk_fwd, dim3(grid), dim3(512), args, LDS_BYTES, stream);
    if (e != hipSuccess) fprintf(stderr, "cooperative launch failed: %s (grid %d)\n", hipGetErrorString(e), grid);
#endif
}
```
